# Optimizing an MI355X kernel written in HIP

```python
import math
import jax
import jax.numpy as jnp
from jax import lax
import numpy as np

D_MODEL = 1024
BATCH = 16
SEQ = 2048
DEPTH = 2

CTX_LEN = 256
GRID_W = 64
N_EVEN = (DEPTH + 1) // 2
N_ODD = DEPTH // 2
ALPHA = (2.0 * DEPTH) ** 0.25
BETA = (8.0 * DEPTH) ** -0.25
N_MOD = 9
D_FF = 2816
LN_EPS = 1e-6
D_FOURIER = D_MODEL // 2
FOURIER_GROUPS = 8
D_HYENA = D_MODEL // 2
HY_ORDER = 2
HY_SHORT = 3
HY_EMB = 33
HY_HID = 64
HY_FAST_DECAY = 0.3
HY_SLOW_DECAY = 1.5
HY_TARGET = 1e-2
EV_IN = D_FOURIER + (HY_ORDER + 1) * D_HYENA
CHUNK = 64
GLA_HEADS = 4
GLA_DK = D_MODEL // 16
GLA_DV = D_MODEL // 8
GLA_RANK = 16
GLA_TAU = 16.0
D_GLA = GLA_HEADS * GLA_DV
HG_HEADS = 4
HG_D = 128
D_HG = HG_HEADS * HG_D
OD_SIZES = (GLA_HEADS * GLA_DK, GLA_HEADS * GLA_DK, D_GLA, D_GLA, GLA_RANK, GLA_RANK,
            D_HG, D_HG, D_HG, D_HG, D_HG)
OD_IN = sum(OD_SIZES)

kernel_name = 'hybrid_fourier_hyena_gla_hgrn2_prefix_dit'


def _split(p, sizes):
    idx = np.cumsum(np.array(sizes))[:-1].tolist()
    return jnp.split(p, idx, axis=-1)


def _ln(x):
    xf = x.astype(jnp.float32)
    mu = jnp.mean(xf, axis=-1, keepdims=True)
    var = jnp.mean(jnp.square(xf - mu), axis=-1, keepdims=True)
    return (xf - mu) * lax.rsqrt(var + LN_EPS)


def _modulate(x, shift, scale):
    return (_ln(x) * (1.0 + scale) + shift).astype(x.dtype)


def _post_ln(x, y, g, b):
    z = ALPHA * x.astype(jnp.float32) + y.astype(jnp.float32)
    return (_ln(z) * g + b).astype(x.dtype)


def _rms_heads(o, g):
    of = o.astype(jnp.float32)
    return of * lax.rsqrt(jnp.mean(jnp.square(of), axis=-1, keepdims=True) + LN_EPS) * g


def _ffn_sublayer(x, shift, scale, gate, w_in, w_out, g, b):
    a, u = jnp.split(_modulate(x, shift, scale) @ w_in, 2, axis=-1)
    y = (jax.nn.silu(a) * u) @ w_out
    return _post_ln(x, 0.5 * gate * y, g, b)


def _fourier_mix(a):
    B, L, C = a.shape
    ag = a.astype(jnp.float32).reshape(B, L, FOURIER_GROUPS, C // FOURIER_GROUPS)
    y = jnp.fft.fft2(ag, axes=(1, 3), norm='ortho').real
    return y.reshape(B, L, C).astype(a.dtype)


def _short_conv(u, w, b):
    up = jnp.pad(u, ((0, 0), (1, 1), (0, 0)))
    return up[:, :-2] * w[0] + up[:, 1:-1] * w[1] + up[:, 2:] * w[2] + b


def _hyena_filters(L, w1, b1, w2, b2, w3, freq):
    f32 = jnp.float32
    t = jnp.linspace(0.0, 1.0, L, dtype=f32)[:, None]
    bands = (HY_EMB - 1) // 2
    fr = jnp.linspace(1e-4, bands - 1, bands, dtype=f32)[None, :]
    idx = jnp.arange(L, dtype=f32)[:, None]
    w = 2.0 * math.pi * idx * fr / L
    z = jnp.concatenate([t, jnp.cos(w), -jnp.sin(w)], axis=-1)
    hdn = jnp.sin(freq * (z @ w1 + b1))
    hdn = jnp.sin(freq * (hdn @ w2 + b2))
    h = (hdn @ w3).astype(f32).reshape(L, 2, HY_ORDER, D_HYENA)
    deltas = jnp.abs(jnp.linspace(math.log(HY_TARGET) / HY_SLOW_DECAY,
                                  math.log(HY_TARGET) / HY_FAST_DECAY, D_HYENA, dtype=f32))
    h = h * jnp.exp(-t * deltas)[:, None, None, :]
    fwd, bwd = h[:, 0], h[:, 1]
    k = jnp.concatenate([fwd, jnp.zeros((1, HY_ORDER, D_HYENA), f32), jnp.flip(bwd[1:], axis=0)], axis=0)
    return k / (jnp.sum(jnp.abs(k), axis=0, keepdims=True) + 1e-6)


def _fft_conv(z, k):
    L = z.shape[1]
    Z = jnp.fft.rfft(z, n=2 * L, axis=1)
    K = jnp.fft.rfft(k, n=2 * L, axis=0)
    return jnp.fft.irfft(Z * K[None], n=2 * L, axis=1)[:, :L]


def _hyena(u, conv_w, conv_b, w1, b1, w2, b2, w3, freq, skip):
    L = u.shape[1]
    u = _short_conv(u, conv_w, conv_b)
    v, x1, x2 = jnp.split(u, 3, axis=-1)
    k = _hyena_filters(L, w1, b1, w2, b2, w3, freq)
    z = v.astype(jnp.float32)
    z = x1 * (_fft_conv(z, k[:, 0]) + z * skip[0])
    z = x2 * (_fft_conv(z, k[:, 1]) + z * skip[1])
    return z.astype(u.dtype)


def _even_mixer(h, w_in, w_out, conv_w, conv_b, w1, b1, w2, b2, w3, freq, skip):
    p = h @ w_in
    a, u = p[..., :D_FOURIER], p[..., D_FOURIER:]
    y = jnp.concatenate([_fourier_mix(a), _hyena(u, conv_w, conv_b, w1, b1, w2, b2, w3, freq, skip)], axis=-1)
    return y @ w_out


def _chunked_gla(q, k, v, g, s0):
    dt = v.dtype
    B, L, H, dk = q.shape
    dv = v.shape[-1]
    n = L // CHUNK
    blk = lambda a: a.astype(jnp.float32).reshape(B, n, CHUNK, H, a.shape[-1])
    q, k, v, g = blk(q), blk(k), blk(v), blk(g)
    G = jnp.cumsum(g, axis=2)
    G_last = G[:, :, -1:]
    q_in = q * jnp.exp(G)
    k_in = k * jnp.exp(-G)
    k_out = k * jnp.exp(G_last - G)
    att = jnp.einsum('bnihd,bnjhd->bnhij', q_in, k_in)
    upto_self = jnp.tril(jnp.ones((CHUNK, CHUNK), dtype=bool))
    att = jnp.where(upto_self, att, 0.0)
    o_intra = jnp.einsum('bnhij,bnjhv->bnihv', att, v)

    def step(S, inp):
        qc, kc, vc, dc = inp
        o = jnp.einsum('bihd,bhdv->bihv', qc, S)
        S = dc[..., None] * S + jnp.einsum('bjhd,bjhv->bhdv', kc, vc)
        return S, o

    xs = (jnp.moveaxis(q_in, 1, 0), jnp.moveaxis(k_out, 1, 0), jnp.moveaxis(v, 1, 0),
          jnp.moveaxis(jnp.exp(G_last[:, :, 0]), 1, 0))
    S, o_inter = lax.scan(step, s0.astype(jnp.float32), xs)
    o = o_intra + jnp.moveaxis(o_inter, 0, 1)
    return o.reshape(B, L, H, dv).astype(dt), S


def _final_state(k, v, g):
    G = jnp.cumsum(g.astype(jnp.float32), axis=1)
    w = jnp.exp(G[:, -1:] - G)
    return jnp.einsum('blhd,blhv->bhdv', k.astype(jnp.float32) * w, v.astype(jnp.float32))


def _flip(a):
    return jnp.flip(a, axis=1)


def _scan_two_way(lat, ctx, need_ctx_out):
    q, kf, gf, kb, gb, v = lat
    cq, ckf, cgf, ckb, cgb, cv = ctx
    B, _, H, dk = kf.shape
    dv = v.shape[-1]
    if need_ctx_out:
        s0 = jnp.zeros((B, H, dk, dv), jnp.float32)
        co_f, sf = _chunked_gla(cq, ckf, cv, cgf, s0)
        co_b, sb = _chunked_gla(_flip(cq), _flip(ckb), _flip(cv), _flip(cgb), s0)
        co = co_f + _flip(co_b)
    else:
        sf = _final_state(ckf, cv, cgf)
        sb = _final_state(_flip(ckb), _flip(cv), _flip(cgb))
        co = None
    o_f, _ = _chunked_gla(q, kf, v, gf, sf)
    o_b, _ = _chunked_gla(_flip(q), _flip(kb), _flip(v), _flip(gb), sb)
    return o_f + _flip(o_b), co


def _odd_mixer(h, hc, w_in, w_out, a_up, a_b, gla_g, lb, hg_g, need_ctx_out):
    B, L, _ = h.shape
    rows = L // GRID_W

    def to_col(a):
        return a.reshape((B, rows, GRID_W) + a.shape[2:]).swapaxes(1, 2).reshape(a.shape)

    def from_col(a):
        return a.reshape((B, GRID_W, rows) + a.shape[2:]).swapaxes(1, 2).reshape(a.shape)

    def features(u):
        lead = u.shape[:2]
        heads = lambda a, H: a.reshape(lead + (H, -1))
        qc, kc, vc, rc, af, ab, qd, ffl, fbl, idd, gd = _split(u @ w_in, OD_SIZES)
        q = heads(qc, GLA_HEADS) * (GLA_DK ** -0.5)
        k = heads(kc, GLA_HEADS)
        v = heads(vc, GLA_HEADS)
        gf = heads(jax.nn.log_sigmoid((af @ a_up[0] + a_b[0]).astype(jnp.float32)) / GLA_TAU, GLA_HEADS)
        gb = heads(jax.nn.log_sigmoid((ab @ a_up[1] + a_b[1]).astype(jnp.float32)) / GLA_TAU, GLA_HEADS)
        ff = lb + (1.0 - lb) * jax.nn.sigmoid(ffl.astype(jnp.float32))
        fb = lb + (1.0 - lb) * jax.nn.sigmoid(fbl.astype(jnp.float32))
        gla = (q, k, gf, k, gb, v)
        hg = (heads(qd, HG_HEADS), heads(1.0 - ff, HG_HEADS), heads(jnp.log(ff), HG_HEADS),
              heads(1.0 - fb, HG_HEADS), heads(jnp.log(fb), HG_HEADS), heads(idd, HG_HEADS))
        return gla, hg, heads(rc, GLA_HEADS), heads(gd, HG_HEADS)

    lat_gla, lat_hg, r, g = features(h)
    ctx_gla, ctx_hg, rc, gc = features(hc)
    o_gla, co_gla = _scan_two_way(lat_gla, ctx_gla, need_ctx_out)
    o_hg, co_hg = _scan_two_way(tuple(to_col(a) for a in lat_hg), ctx_hg, need_ctx_out)
    o_hg = from_col(o_hg)

    def readout(og, oh, r_, g_):
        yg = _rms_heads(og, gla_g) * jax.nn.silu(r_.astype(jnp.float32))
        yh = _rms_heads(oh.astype(jnp.float32) * jax.nn.sigmoid(g_.astype(jnp.float32)), hg_g)
        y = jnp.concatenate([yg.reshape(og.shape[:2] + (D_GLA,)), yh.reshape(oh.shape[:2] + (D_HG,))], axis=-1)
        return y.astype(h.dtype) @ w_out

    y = readout(o_gla, o_hg, r, g)
    yc = readout(co_gla, co_hg, rc, gc) if need_ctx_out else None
    return y, yc


def setup_inputs(seed: int = 0) -> dict:
    key = jax.random.key(seed)
    ks = iter(jax.random.split(key, 28))
    D = D_MODEL

    def nrm(shape, scale):
        return jax.random.normal(next(ks), shape, jnp.float32) * scale

    return {
        'x': nrm((BATCH, SEQ, D), 1.0),
        'c': nrm((BATCH, D), 1.0),
        'ctx': nrm((BATCH, CTX_LEN, D), 1.0),
        'c_ctx': nrm((D,), 1.0),
        'mod_w': nrm((DEPTH, D, N_MOD * D), D ** -0.5),
        'mod_b': nrm((DEPTH, N_MOD * D), 0.02),
        'ffn_w_in': nrm((DEPTH, 2, D, 2 * D_FF), D ** -0.5),
        'ffn_w_out': nrm((DEPTH, 2, D_FF, D), D_FF ** -0.5 * BETA),
        'ln_g': 1.0 + nrm((DEPTH, 3, D), 0.02),
        'ln_b': nrm((DEPTH, 3, D), 0.02),
        'ev_w_in': nrm((N_EVEN, D, EV_IN), D ** -0.5),
        'ev_w_out': nrm((N_EVEN, D_FOURIER + D_HYENA, D), (D_FOURIER + D_HYENA) ** -0.5 * BETA),
        'hy_conv_w': nrm((N_EVEN, HY_SHORT, 3 * D_HYENA), HY_SHORT ** -0.5),
        'hy_conv_b': nrm((N_EVEN, 3 * D_HYENA), 0.02),
        'hy_w1': nrm((N_EVEN, HY_EMB, HY_HID), HY_EMB ** -0.5),
        'hy_b1': nrm((N_EVEN, HY_HID), 0.02),
        'hy_w2': nrm((N_EVEN, HY_HID, HY_HID), HY_HID ** -0.5),
        'hy_b2': nrm((N_EVEN, HY_HID), 0.02),
        'hy_w3': nrm((N_EVEN, HY_HID, 2 * HY_ORDER * D_HYENA), HY_HID ** -0.5),
        'hy_freq': 1.0 + nrm((N_EVEN, HY_HID), 0.02),
        'hy_skip': nrm((N_EVEN, HY_ORDER, D_HYENA), 1.0),
        'od_w_in': nrm((N_ODD, D, OD_IN), D ** -0.5),
        'od_w_out': nrm((N_ODD, D_GLA + D_HG, D), (D_GLA + D_HG) ** -0.5 * BETA),
        'gla_a_up': nrm((N_ODD, 2, GLA_RANK, GLA_HEADS * GLA_DK), GLA_RANK ** -0.5),
        'gla_a_b': nrm((N_ODD, 2, GLA_HEADS * GLA_DK), 0.02),
        'gla_norm_g': 1.0 + nrm((N_ODD, GLA_DV), 0.02),
        'hg_lb': nrm((DEPTH, D_HG), 0.1),
        'hg_norm_g': 1.0 + nrm((N_ODD, HG_D), 0.02),
    }


def reference(x, c, ctx, c_ctx, mod_w, mod_b, ffn_w_in, ffn_w_out, ln_g, ln_b,
              ev_w_in, ev_w_out, hy_conv_w, hy_conv_b, hy_w1, hy_b1, hy_w2, hy_b2, hy_w3, hy_freq, hy_skip,
              od_w_in, od_w_out, gla_a_up, gla_a_b, gla_norm_g, hg_lb, hg_norm_g):
    B = x.shape[0]
    sm = jax.nn.softmax(hg_lb.astype(jnp.float32), axis=0)
    lower_bounds = jnp.cumsum(sm, axis=0) - sm[0]
    xc = ctx
    for i in range(DEPTH):
        last = i == DEPTH - 1
        odd = i % 2 == 1
        ctx_used = odd or not last
        j = i // 2
        m = (jax.nn.silu(c) @ mod_w[i] + mod_b[i]).reshape(B, N_MOD, 1, D_MODEL)
        mc = (jax.nn.silu(c_ctx) @ mod_w[i] + mod_b[i]).reshape(N_MOD, D_MODEL)
        x = _ffn_sublayer(x, m[:, 0], m[:, 1], m[:, 2], ffn_w_in[i, 0], ffn_w_out[i, 0], ln_g[i, 0], ln_b[i, 0])
        if ctx_used:
            xc = _ffn_sublayer(xc, mc[0], mc[1], mc[2], ffn_w_in[i, 0], ffn_w_out[i, 0], ln_g[i, 0], ln_b[i, 0])
        h = _modulate(x, m[:, 3], m[:, 4])
        if odd:
            hc = _modulate(xc, mc[3], mc[4])
            y, yc = _odd_mixer(h, hc, od_w_in[j], od_w_out[j], gla_a_up[j], gla_a_b[j], gla_norm_g[j],
                               lower_bounds[i], hg_norm_g[j], not last)
        else:
            ev = (ev_w_in[j], ev_w_out[j], hy_conv_w[j], hy_conv_b[j], hy_w1[j], hy_b1[j],
                  hy_w2[j], hy_b2[j], hy_w3[j], hy_freq[j], hy_skip[j])
            y = _even_mixer(h, *ev)
            yc = _even_mixer(_modulate(xc, mc[3], mc[4]), *ev) if not last else None
        x = _post_ln(x, m[:, 5] * y, ln_g[i, 1], ln_b[i, 1])
        x = _ffn_sublayer(x, m[:, 6], m[:, 7], m[:, 8], ffn_w_in[i, 1], ffn_w_out[i, 1], ln_g[i, 2], ln_b[i, 2])
        if not last:
            xc = _post_ln(xc, mc[5] * yc, ln_g[i, 1], ln_b[i, 1])
            xc = _ffn_sublayer(xc, mc[6], mc[7], mc[8], ffn_w_in[i, 1], ffn_w_out[i, 1], ln_g[i, 2], ln_b[i, 2])
    return x
```

```cpp
#include <hip/hip_runtime.h>
#include <hip/hip_cooperative_groups.h>
#include <cstdio>
namespace cg = cooperative_groups;

typedef unsigned short u16;
using bf16x8 = __attribute__((ext_vector_type(8))) short;
using f32x4 = __attribute__((ext_vector_type(4))) float;

#define NT 36864
#define NLAT 32768
#define DM 1024
#define DFF 2816
#define NTHR 256
#define LDS_BYTES 79872
#define ALPHA_F 1.4142135623730951f
#define LN_EPS 1e-6f
#define NPHASE 25
#define DUPPH (-1)
#define DUPMASK 0

constexpr size_t SZ_FFN_IN = (size_t)5632 * 1024 * 2;
constexpr size_t SZ_FFN_OUT = (size_t)1024 * 2816 * 2;
constexpr size_t OFF_W1_FFN_IN0 = 0;
constexpr size_t OFF_W1_FFN_IN1 = OFF_W1_FFN_IN0 + SZ_FFN_IN;
constexpr size_t OFF_W1_FFN_OUT0 = OFF_W1_FFN_IN1 + SZ_FFN_IN;
constexpr size_t OFF_W1_FFN_OUT1 = OFF_W1_FFN_OUT0 + SZ_FFN_OUT;
constexpr size_t OFF_W1_OD_IN = OFF_W1_FFN_OUT1 + SZ_FFN_OUT;
constexpr size_t OFF_W1_OD_OUT = OFF_W1_OD_IN + (size_t)4352 * 1024 * 2;
constexpr size_t OFF_MOD = OFF_W1_OD_OUT + (size_t)1024 * 1024 * 2;
constexpr size_t OFF_LB = OFF_MOD + (size_t)2 * 17 * 9216 * 4;
constexpr size_t OFF_BAR = OFF_LB + 2048;
constexpr size_t OFF_XC = OFF_BAR + 16384;
constexpr size_t OFF_H = OFF_XC + (size_t)4096 * 1024 * 4;
constexpr size_t OFF_W0_FFN_IN0 = OFF_H + (size_t)NT * 1024 * 2;
constexpr size_t OFF_W0_FFN_IN1 = OFF_W0_FFN_IN0 + SZ_FFN_IN;
constexpr size_t OFF_W0_FFN_OUT0 = OFF_W0_FFN_IN1 + SZ_FFN_IN;
constexpr size_t OFF_W0_FFN_OUT1 = OFF_W0_FFN_OUT0 + SZ_FFN_OUT;
constexpr size_t OFF_W0_EV_IN = OFF_W0_FFN_OUT1 + SZ_FFN_OUT;
constexpr size_t OFF_W0_EV_OUT = OFF_W0_EV_IN + (size_t)2560 * 1024 * 2;
constexpr size_t OFF_DC = OFF_W0_EV_OUT + (size_t)1024 * 1024 * 2;
constexpr size_t OFF_DS = OFF_DC + (size_t)2048 * 2048 * 2;
constexpr size_t OFF_HD2 = OFF_DS + (size_t)2048 * 2048 * 2;
constexpr size_t OFF_FR = OFF_HD2 + (size_t)2304 * 64 * 4;
constexpr size_t OFF_S = OFF_FR + (size_t)(2048 * 2048 + 2048 * 256) * 4;
constexpr size_t OFF_H1 = OFF_S;
constexpr size_t OFF_Y = OFF_H1 + (size_t)NT * DFF * 2;

constexpr size_t OFF_T = OFF_S;
constexpr size_t OFF_V = OFF_T + (size_t)2560 * NT * 2;
constexpr size_t OFF_YE = OFF_T + (size_t)1024 * NT * 2;
constexpr size_t OFF_PROJ = OFF_W0_FFN_IN0;
constexpr size_t OFF_O = OFF_PROJ + (size_t)NT * 4128 * 2;
constexpr size_t OFF_YO = OFF_PROJ;
constexpr size_t WS_NEED = OFF_V + (size_t)1536 * NT * 2;
static_assert(OFF_O + (size_t)NLAT * 1024 * 2 <= (size_t)512 * 1024 * 1024 && WS_NEED <= (size_t)512 * 1024 * 1024, "workspace");

struct Params {
  const float *x, *c, *ctx, *c_ctx, *mod_w, *mod_b, *ffn_w_in, *ffn_w_out, *ln_g, *ln_b,
      *ev_w_in, *ev_w_out, *hy_conv_w, *hy_conv_b, *hy_w1, *hy_b1, *hy_w2, *hy_b2, *hy_w3, *hy_freq, *hy_skip,
      *od_w_in, *od_w_out, *gla_a_up, *gla_a_b, *gla_norm_g, *hg_lb, *hg_norm_g;
  float* out;
  char* ws;
};

__device__ __forceinline__ u16 f2bf(float f) {
  unsigned u = __float_as_uint(f);
  u += 0x7fffu + ((u >> 16) & 1u);
  return (u16)(u >> 16);
}
__device__ __forceinline__ float bf2f(u16 h) { return __uint_as_float(((unsigned)h) << 16); }
__device__ __forceinline__ unsigned pack2bf(float a, float b) { return (unsigned)f2bf(a) | ((unsigned)f2bf(b) << 16); }
__device__ __forceinline__ float wave_sum(float v) {
#pragma unroll
  for (int o = 32; o > 0; o >>= 1) v += __shfl_xor(v, o);
  return v;
}

#define XB_TMO      128
#define XB_XCNT(j)  (256  + 64 * (j))
#define XB_XSUB(j)  (1280 + 64 * (j))
#define XB_XGEN(j)  (2304 + 64 * (j))
#define XB_TOP      3328
#define XB_TOPGEN   3392
#define XCD_BAR_WORDS 3456
#define XB_SPIN_CAP (1u << 18)
#define LAS __attribute__((address_space(3)))

__device__ __forceinline__ unsigned xb_ld(unsigned* p)              { return __hip_atomic_load(p, __ATOMIC_RELAXED, __HIP_MEMORY_SCOPE_AGENT); }
__device__ __forceinline__ unsigned xb_add(unsigned* p, unsigned v) { return __hip_atomic_fetch_add(p, v, __ATOMIC_RELAXED, __HIP_MEMORY_SCOPE_AGENT); }
__device__ __forceinline__ unsigned xb_xcc_id() { return (unsigned)__builtin_amdgcn_s_getreg((3 << 11) | 20) & 0xFu; }
#define XB_SPIN(cond, bar) do { unsigned _sp = 0; while (cond) { __builtin_amdgcn_s_sleep(1); \
    if ((++_sp & 255u) == 0u) { if (xb_ld(&(bar)[XB_TMO])) break; if (_sp > XB_SPIN_CAP) { atomicAdd(&(bar)[XB_TMO], 1u); break; } } } } while (0)

struct XcdBarrier {
    unsigned* bar; unsigned x;
    volatile LAS unsigned* st;
};

__device__ __forceinline__ XcdBarrier xcd_barrier_post(unsigned* bar, volatile LAS unsigned* st) {
    XcdBarrier b; b.bar = bar; b.x = xb_xcc_id(); b.st = st;
    if (threadIdx.x == 0) (void)xb_add(&bar[XB_XCNT(b.x)], 1u);
    return b;
}
__device__ __forceinline__ void xcd_barrier_complete(unsigned* bar, unsigned x, unsigned& nloc, unsigned& nx) {
    const unsigned G = gridDim.x * gridDim.y * gridDim.z;
    unsigned sum, cnt, mine, sp = 0u;
    for (;;) {
        sum = 0u; cnt = 0u; mine = 0u;
#pragma unroll
        for (unsigned j = 0; j < 16; ++j) { const unsigned c = xb_ld(&bar[XB_XCNT(j)]); sum += c; cnt += (c > 0u) ? 1u : 0u; mine = (j == x) ? c : mine; }
        if (sum == G) break;
        __builtin_amdgcn_s_sleep(1);
        if ((++sp & 255u) == 0u) { if (xb_ld(&bar[XB_TMO])) break; if (sp > XB_SPIN_CAP) { atomicAdd(&bar[XB_TMO], 1u); break; } }
    }
    nloc = mine > 0u ? mine : 1u; nx = cnt > 0u ? cnt : 1u;
}

__device__ __forceinline__ void xcd_barrier(const XcdBarrier& b) {
    asm volatile("s_waitcnt vmcnt(0)" ::: "memory");
    __syncthreads();
    if (threadIdx.x == 0) {
        unsigned* bar = b.bar;
        __builtin_amdgcn_s_waitcnt(0);
        unsigned nloc = b.st[0], nx = b.st[1];
        if (nloc == 0u) { xcd_barrier_complete(bar, b.x, nloc, nx); b.st[0] = nloc; b.st[1] = nx; }
        const unsigned old = xb_add(&bar[XB_XSUB(b.x)], 1u);
        const unsigned gen = old / nloc;
        if (old + 1u == (gen + 1u) * nloc) {
            __builtin_amdgcn_fence(__ATOMIC_RELEASE, "agent");
            asm volatile("s_waitcnt vmcnt(0)" ::: "memory");
            const unsigned og = xb_add(&bar[XB_TOP], 1u);
            const unsigned tg = og / nx;
            if (og + 1u == (tg + 1u) * nx) xb_add(&bar[XB_TOPGEN], 1u);
            else XB_SPIN(xb_ld(&bar[XB_TOPGEN]) == tg, bar);
            __builtin_amdgcn_fence(__ATOMIC_ACQUIRE, "agent");
            xb_add(&bar[XB_XGEN(b.x)], 1u);
            asm volatile("s_waitcnt vmcnt(0)" ::: "memory");
        } else {
            XB_SPIN(xb_ld(&bar[XB_XGEN(b.x)]) == gen, bar);
            __builtin_amdgcn_fence(__ATOMIC_ACQUIRE, "agent");
            asm volatile("s_waitcnt vmcnt(0)" ::: "memory");
        }
    }
    __syncthreads();
}


#define GAS __attribute__((address_space(1)))
__device__ __forceinline__ void gemm_core(int tidx_, int bidx_, char* smem, const u16* __restrict__ Ag, long lda,
                                          const u16* __restrict__ Bg, long ldb, int K, f32x4 (&acc)[4][4], bool pre_issued) {
  const int tid = tidx_, lane = tid & 63, wid = tid >> 6, wr = wid >> 1, wc = wid & 1;
  const int lr = lane >> 3, lc = (lane & 7) ^ lr;
  const u16* ap = Ag + (long)(wid * 8 + lr) * lda + lc * 8;
  const u16* bp = Bg + (long)(wid * 8 + lr) * ldb + lc * 8;
  const int soff = wid * 1024 + lane * 16;
#define GLDS(buf, kofs) do { \
    _Pragma("unroll") for (int i_ = 0; i_ < 4; ++i_) { \
      __builtin_amdgcn_global_load_lds((const GAS void*)(ap + (long)(32 * i_) * lda + (kofs)), (LAS void*)((buf) + soff + i_ * 4096), 16, 0, 0); \
      __builtin_amdgcn_global_load_lds((const GAS void*)(bp + (long)(32 * i_) * ldb + (kofs)), (LAS void*)((buf) + 16384 + soff + i_ * 4096), 16, 0, 0); \
    } } while (0)
  if (!pre_issued) GLDS(smem, 0);
  asm volatile("s_waitcnt vmcnt(0)" ::: "memory");
  __syncthreads();
  const int nk = K >> 6;
  const int fr = lane & 15, fq = lane >> 4;
  const int aoff = (wr * 64 + fr) * 128;
  const int boff = 16384 + (wc * 64 + fr) * 128;
  for (int kt = 0; kt < nk; ++kt) {
    if (kt + 1 < nk) GLDS(smem + ((kt + 1) & 1) * 32768, (kt + 1) * 64);
    const char* sb = smem + (kt & 1) * 32768;
#pragma unroll
    for (int kk = 0; kk < 2; ++kk) {
      bf16x8 a[4], b[4];
      const int ch = ((kk * 4 + fq) ^ (fr & 7)) << 4;
#pragma unroll
      for (int m = 0; m < 4; ++m) a[m] = *(const bf16x8*)(sb + aoff + m * 2048 + ch);
#pragma unroll
      for (int n = 0; n < 4; ++n) b[n] = *(const bf16x8*)(sb + boff + n * 2048 + ch);
      __builtin_amdgcn_s_setprio(1);
#pragma unroll
      for (int m = 0; m < 4; ++m)
#pragma unroll
        for (int n = 0; n < 4; ++n) acc[m][n] = __builtin_amdgcn_mfma_f32_16x16x32_bf16(a[m], b[n], acc[m][n], 0, 0, 0);
      __builtin_amdgcn_s_setprio(0);
    }
    asm volatile("s_waitcnt vmcnt(0)" ::: "memory");
    __syncthreads();
  }
#undef GLDS
}

__device__ __forceinline__ void gemm_issue_first(int tidx_, char* smem, const u16* __restrict__ Ag, long lda,
                                                 const u16* __restrict__ Bg, long ldb) {
  const int lane = tidx_ & 63, wid = tidx_ >> 6;
  const int lr = lane >> 3, lc = (lane & 7) ^ lr;
  const u16* ap = Ag + (long)(wid * 8 + lr) * lda + lc * 8;
  const u16* bp = Bg + (long)(wid * 8 + lr) * ldb + lc * 8;
  const int soff = wid * 1024 + lane * 16;
#pragma unroll
  for (int i_ = 0; i_ < 4; ++i_) {
    __builtin_amdgcn_global_load_lds((const GAS void*)(ap + (long)(32 * i_) * lda), (LAS void*)(smem + soff + i_ * 4096), 16, 0, 0);
    __builtin_amdgcn_global_load_lds((const GAS void*)(bp + (long)(32 * i_) * ldb), (LAS void*)(smem + 16384 + soff + i_ * 4096), 16, 0, 0);
  }
}

__device__ __forceinline__ void gemm_core256(int tidx_, char* smem, const u16* __restrict__ Ag, long ars, long aks,
                                             const u16* __restrict__ Bg, long brs, long bks, int K, f32x4 (&acc)[4][8]) {
  const int lane = tidx_ & 63, wid = tidx_ >> 6, wr = wid >> 1, wc = wid & 1;
  const int rr = lane >> 2, cs = (lane & 3) ^ ((rr >> 2) & 3);
  const u16* ap = Ag + (long)(wid * 32 + rr) * ars + cs * 8;
  const u16* bp = Bg + (long)(wid * 64 + rr) * brs + cs * 8;
  const int sa = wid * 2048 + lane * 16, sbo = 8192 + wid * 4096 + lane * 16;
#define GLDS2(buf, kt_) do { \
    __builtin_amdgcn_global_load_lds((const GAS void*)(ap + (long)(kt_) * aks), (LAS void*)((buf) + sa), 16, 0, 0); \
    __builtin_amdgcn_global_load_lds((const GAS void*)(ap + 16 * ars + (long)(kt_) * aks), (LAS void*)((buf) + sa + 1024), 16, 0, 0); \
    _Pragma("unroll") for (int i_ = 0; i_ < 4; ++i_) \
      __builtin_amdgcn_global_load_lds((const GAS void*)(bp + (long)(16 * i_) * brs + (long)(kt_) * bks), (LAS void*)((buf) + sbo + i_ * 1024), 16, 0, 0); \
  } while (0)
  const int nk = K >> 5;
  GLDS2(smem, 0);
  if (nk > 1) GLDS2(smem + 24576, 1);
  const int fr = lane & 15, fq = lane >> 4;
  const int fsw = (fq ^ ((fr >> 2) & 3)) << 4;
  const int aoff = (wr * 64 + fr) * 64 + fsw;
  const int boff = 8192 + (wc * 128 + fr) * 64 + fsw;
  int slot = 0, slot2 = 2;
  for (int kt = 0; kt < nk; ++kt) {
    if (kt + 1 < nk) asm volatile("s_waitcnt vmcnt(6)" ::: "memory");
    else asm volatile("s_waitcnt vmcnt(0)" ::: "memory");
    asm volatile("s_waitcnt lgkmcnt(0)" ::: "memory");
    __builtin_amdgcn_s_barrier();
    asm volatile("" ::: "memory");
    if (kt + 2 < nk) GLDS2(smem + slot2 * 24576, kt + 2);
    const char* sb = smem + slot * 24576;
    bf16x8 a[4], b[8];
#pragma unroll
    for (int m = 0; m < 4; ++m) a[m] = *(const bf16x8*)(sb + aoff + m * 1024);
#pragma unroll
    for (int n = 0; n < 8; ++n) b[n] = *(const bf16x8*)(sb + boff + n * 1024);
    __builtin_amdgcn_s_setprio(1);
#pragma unroll
    for (int m = 0; m < 4; ++m)
#pragma unroll
      for (int n = 0; n < 8; ++n) acc[m][n] = __builtin_amdgcn_mfma_f32_16x16x32_bf16(a[m], b[n], acc[m][n], 0, 0, 0);
    __builtin_amdgcn_s_setprio(0);
    slot = (slot == 2) ? 0 : slot + 1;
    slot2 = (slot2 == 2) ? 0 : slot2 + 1;
  }
  asm volatile("s_waitcnt lgkmcnt(0)" ::: "memory");
  __builtin_amdgcn_s_barrier();
  asm volatile("" ::: "memory");
#undef GLDS2
}

enum { EPI_SWIGLU = 0, EPI_BF16 = 1, EPI_BF16_T = 2, EPI_F16 = 3 };

template <int NF>
__device__ __forceinline__ void gemm_epilogue(int tidx_, int bidx_, f32x4 (&acc)[4][NF], int epi, void* C, long ldc, int row0, int col0,
                                              float scale, int ncols) {
  const int lane = tidx_ & 63, wid = tidx_ >> 6, wr = wid >> 1, wc = wid & 1;
  const int fr = lane & 15, fq = lane >> 4;
  if (epi == EPI_SWIGLU) {
    u16* out = (u16*)C;
#pragma unroll
    for (int m = 0; m < 4; ++m)
#pragma unroll
      for (int pp = 0; pp < NF / 2; ++pp) {
        const int hc = ((col0 + wc * (NF * 16)) >> 1) + pp * 16 + fr;
#pragma unroll
        for (int j = 0; j < 4; ++j) {
          const int row = row0 + wr * 64 + m * 16 + fq * 4 + j;
          const float a = acc[m][2 * pp][j], u = acc[m][2 * pp + 1][j];
          const float s = a * __builtin_amdgcn_rcpf(1.f + __expf(-a));
          out[((long)(hc >> 5) * NT + row) * 32 + (hc & 31)] = f2bf(s * u);
        }
      }
  } else if (epi == EPI_BF16) {
    u16* out = (u16*)C;
#pragma unroll
    for (int m = 0; m < 4; ++m)
#pragma unroll
      for (int n = 0; n < NF; ++n) {
        const int col = col0 + wc * (NF * 16) + n * 16 + fr;
#pragma unroll
        for (int j = 0; j < 4; ++j) {
          const int row = row0 + wr * 64 + m * 16 + fq * 4 + j;
          out[(long)row * ldc + col] = f2bf(acc[m][n][j] * scale);
        }
      }
  } else if (epi == EPI_BF16_T) {
    u16* out = (u16*)C;
#pragma unroll
    for (int m = 0; m < 4; ++m)
#pragma unroll
      for (int n = 0; n < NF; ++n) {
        const int col = col0 + wc * (NF * 16) + n * 16 + fr;
        const int row = row0 + wr * 64 + m * 16 + fq * 4;
        uint2 v;
        v.x = pack2bf(acc[m][n][0], acc[m][n][1]);
        v.y = pack2bf(acc[m][n][2], acc[m][n][3]);
        *(uint2*)(out + (long)col * ldc + row) = v;
      }
  } else {
    _Float16* out = (_Float16*)C;
#pragma unroll
    for (int m = 0; m < 4; ++m)
#pragma unroll
      for (int n = 0; n < NF; ++n) {
        const int col = col0 + wc * (NF * 16) + n * 16 + fr;
        if (col < ncols) {
#pragma unroll
          for (int j = 0; j < 4; ++j) {
            const int row = row0 + wr * 64 + m * 16 + fq * 4 + j;
            out[(long)row * ldc + col] = (_Float16)acc[m][n][j];
          }
        }
      }
  }
}

struct GemmD {
  const u16 *A0, *A1, *B0, *B1;
  long lda, ldb, bsB, brs, bks, ars, aks;
  void* C;
  long ldc;
  int K, nseg, Mt, Ntl, nbatch, bsCrow, crow0, epi, ncols, wide;
  float scale;
};

__device__ __forceinline__ void gemm_tile_decode(const GemmD& d, int idx, int x, int Rx, int G, int wlast, int& b, int& mt, int& nt) {
  const int gsh = d.wide ? 2 : 3;
  int rl;
  if (idx < ((G * Rx) << gsh)) {
    const int ntg = idx / (Rx << gsh), rem = idx - ntg * (Rx << gsh);
    rl = rem >> gsh;
    nt = (ntg << gsh) + (rem & ((1 << gsh) - 1));
  } else {
    const int rem = idx - ((G * Rx) << gsh);
    rl = rem / wlast;
    nt = (G << gsh) + (rem - rl * wlast);
  }
  const int R = x * Rx + rl;
  b = R / d.Mt;
  mt = R - b * d.Mt;
}

__device__ __forceinline__ void gemm_job(int tidx_, int bidx_, char* smem, const GemmD& d) {
  const int x = bidx_ & 7, jloc = bidx_ >> 3, nloc = gridDim.x >> 3;
  const int Rx = (d.nbatch * d.Mt) >> 3;
  const int gsh = d.wide ? 2 : 3;
  const int G = d.Ntl >> gsh, wlast = d.Ntl - (G << gsh);
  const int total = Rx * d.Ntl;
  int b = 0, mt = 0, nt = 0;
  if (d.wide) {
    if (bidx_ >= (int)(gridDim.x >> 1)) __builtin_amdgcn_s_sleep(6);
    for (int idx = jloc; idx < total; idx += nloc) {
      gemm_tile_decode(d, idx, x, Rx, G, wlast, b, mt, nt);
      f32x4 acc[4][8];
#pragma unroll
      for (int m = 0; m < 4; ++m)
#pragma unroll
        for (int n = 0; n < 8; ++n) acc[m][n] = f32x4{0.f, 0.f, 0.f, 0.f};
      for (int s = 0; s < d.nseg; ++s)
        gemm_core256(tidx_, smem, (s ? d.A1 : d.A0) + (long)mt * 128 * (d.ars ? d.ars : d.lda), d.ars ? d.ars : d.lda, d.ars ? d.aks : 32,
                     (s ? d.B1 : d.B0) + (long)nt * 256 * (d.brs ? d.brs : d.ldb) + (long)b * d.bsB,
                     d.brs ? d.brs : d.ldb, d.brs ? d.bks : 32, d.K, acc);
      gemm_epilogue<8>(tidx_, bidx_, acc, d.epi, d.C, d.ldc, d.crow0 + b * d.bsCrow + mt * 128, nt * 256, d.scale, d.ncols);
    }
    return;
  }
  if (jloc < total) {
    gemm_tile_decode(d, jloc, x, Rx, G, wlast, b, mt, nt);
    gemm_issue_first(tidx_, smem, d.A0 + (long)mt * 128 * d.lda, d.lda, d.B0 + (long)nt * 128 * d.ldb + (long)b * d.bsB, d.ldb);
  }
  for (int idx = jloc; idx < total; idx += nloc) {
    f32x4 acc[4][4];
#pragma unroll
    for (int m = 0; m < 4; ++m)
#pragma unroll
      for (int n = 0; n < 4; ++n) acc[m][n] = f32x4{0.f, 0.f, 0.f, 0.f};
    for (int s = 0; s < d.nseg; ++s) {
      const u16* A = s ? d.A1 : d.A0;
      const u16* B = s ? d.B1 : d.B0;
      gemm_core(tidx_, bidx_, smem, A + (long)mt * 128 * d.lda, d.lda, B + (long)nt * 128 * d.ldb + (long)b * d.bsB, d.ldb, d.K, acc, s == 0);
    }
    const int crow = d.crow0 + b * d.bsCrow + mt * 128, ccol = nt * 128;
    if (idx + nloc < total) {
      gemm_tile_decode(d, idx + nloc, x, Rx, G, wlast, b, mt, nt);
      gemm_issue_first(tidx_, smem, d.A0 + (long)mt * 128 * d.lda, d.lda, d.B0 + (long)nt * 128 * d.ldb + (long)b * d.bsB, d.ldb);
    }
    gemm_epilogue<4>(tidx_, bidx_, acc, d.epi, d.C, d.ldc, crow, ccol, d.scale, d.ncols);
  }
}

__device__ __forceinline__ void convert_job(int tidx_, int bidx_, char* smem, const float* __restrict__ src, int pitch, int K, int nsrc, int Nout, u16* dst, int map, long brs, long bks) {
  float* t = (float*)smem;
  const int tilesN = Nout >> 6, tilesK = K >> 6;
  for (int tt = bidx_; tt < tilesN * tilesK; tt += gridDim.x) {
    const int n0 = (tt % tilesN) * 64, k0 = (tt / tilesN) * 64;
    for (int idx = tidx_; idx < 1024; idx += NTHR) {
      const int kk = idx >> 4, xx = (idx & 15) * 4;
      const int n = n0 + xx;
      int sc = n;
      if (map == 1) {
        const int q = n >> 5, w = n & 31;
        sc = (w < 16) ? (q * 16 + w) : (DFF + q * 16 + w - 16);
      }
      const float4 vv = *(const float4*)(src + (long)(k0 + kk) * pitch + min(sc, nsrc - 4));
      const bool ok = sc < nsrc;
      t[kk * 65 + xx] = ok ? vv.x : 0.f;
      t[kk * 65 + xx + 1] = ok ? vv.y : 0.f;
      t[kk * 65 + xx + 2] = ok ? vv.z : 0.f;
      t[kk * 65 + xx + 3] = ok ? vv.w : 0.f;
    }
    __syncthreads();
    for (int idx = tidx_; idx < 512; idx += NTHR) {
      const int xx = idx >> 3, cc = idx & 7;
      uint4 v;
      v.x = pack2bf(t[(cc * 8 + 0) * 65 + xx], t[(cc * 8 + 1) * 65 + xx]);
      v.y = pack2bf(t[(cc * 8 + 2) * 65 + xx], t[(cc * 8 + 3) * 65 + xx]);
      v.z = pack2bf(t[(cc * 8 + 4) * 65 + xx], t[(cc * 8 + 5) * 65 + xx]);
      v.w = pack2bf(t[(cc * 8 + 6) * 65 + xx], t[(cc * 8 + 7) * 65 + xx]);
      *(uint4*)(dst + (long)(n0 + xx) * brs + (long)((k0 + cc * 8) >> 5) * bks + ((k0 + cc * 8) & 31)) = v;
    }
    __syncthreads();
  }
}

__device__ __forceinline__ void mod_gemv(int tidx_, int bidx_, char* smem, const Params& p, float* modv) {
  float* s = (float*)smem;
  const int tid = tidx_, lane = tid & 63, wid = tid >> 6;
  for (int u = bidx_; u < 288; u += gridDim.x) {
    for (int idx = tid; idx < 17 * 1024; idx += NTHR) {
      const int r = idx >> 10, k = idx & 1023;
      const float v = (r < 16) ? p.c[r * 1024 + k] : p.c_ctx[k];
      s[idx] = v / (1.f + expf(-v));
    }
    __syncthreads();
    const int layer = u / 144, cb = (u % 144) * 64;
    const float* W = p.mod_w + (long)layer * 1024 * 9216 + cb + lane;
    float acc[17];
#pragma unroll
    for (int r = 0; r < 17; ++r) acc[r] = 0.f;
    const int kb = wid * 256;
#pragma unroll 1
    for (int k0 = kb; k0 < kb + 256; k0 += 16) {
      float w[16];
#pragma unroll
      for (int i = 0; i < 16; ++i) w[i] = W[(long)(k0 + i) * 9216];
#pragma unroll
      for (int i = 0; i < 16; ++i)
#pragma unroll
        for (int r = 0; r < 17; ++r) acc[r] += s[r * 1024 + k0 + i] * w[i];
    }
    __syncthreads();
#pragma unroll
    for (int r = 0; r < 17; ++r) s[(wid * 17 + r) * 64 + lane] = acc[r];
    __syncthreads();
    for (int idx = tid; idx < 17 * 64; idx += NTHR) {
      const int r = idx >> 6, cc = idx & 63;
      const float v = s[(0 * 17 + r) * 64 + cc] + s[(1 * 17 + r) * 64 + cc] + s[(2 * 17 + r) * 64 + cc] + s[(3 * 17 + r) * 64 + cc];
      modv[((long)layer * 17 + r) * 9216 + cb + cc] = v + p.mod_b[layer * 9216 + cb + cc];
    }
    __syncthreads();
  }
}

#define NRW 4
__device__ __forceinline__ void rowpass(int tidx_, int bidx_, const float* xs_lat, const float* xs_ctx, float* xd_lat, float* xd_ctx, bool do_post,
                        const u16* y, const float* modL, int gi, float gscale, const float* lng, const float* lnb,
                        const float* modN, int si, int ci, u16* h, int nrows) {
  const int lane = tidx_ & 63, wid = tidx_ >> 6;
  for (int rb = (bidx_ * 4 + wid) * NRW; rb < nrows; rb += gridDim.x * 4 * NRW) {
    const int b = (rb < NLAT) ? (rb >> 11) : 16;
    const float* xs = (rb < NLAT) ? xs_lat + (long)rb * DM : xs_ctx + (long)(rb - NLAT) * DM;
    float* xd = (rb < NLAT) ? xd_lat + (long)rb * DM : xd_ctx + (long)(rb - NLAT) * DM;
    float v[NRW][16];
#pragma unroll
    for (int q = 0; q < NRW; ++q)
#pragma unroll
      for (int i = 0; i < 4; ++i) {
        typedef float f4v __attribute__((ext_vector_type(4)));
        const f4v t = __builtin_nontemporal_load((const f4v*)(xs + q * DM + i * 256 + lane * 4));
        v[q][4 * i] = t.x; v[q][4 * i + 1] = t.y; v[q][4 * i + 2] = t.z; v[q][4 * i + 3] = t.w;
      }
    if (do_post) {
      if (y) {
        const float* gate = modL + (long)b * 9216 + gi * 1024;
        uint2 yv[NRW][4];
#pragma unroll
        for (int q = 0; q < NRW; ++q)
#pragma unroll
          for (int i = 0; i < 4; ++i) {
            typedef unsigned u2v __attribute__((ext_vector_type(2)));
            const u2v yy = __builtin_nontemporal_load((const u2v*)(y + (long)(rb + q) * DM + i * 256 + lane * 4));
            yv[q][i].x = yy.x; yv[q][i].y = yy.y;
          }
#pragma unroll
        for (int i = 0; i < 4; ++i) {
          const float4 g = *(const float4*)(gate + i * 256 + lane * 4);
#pragma unroll
          for (int q = 0; q < NRW; ++q) {
            v[q][4 * i] = ALPHA_F * v[q][4 * i] + gscale * g.x * bf2f((u16)(yv[q][i].x & 0xffff));
            v[q][4 * i + 1] = ALPHA_F * v[q][4 * i + 1] + gscale * g.y * bf2f((u16)(yv[q][i].x >> 16));
            v[q][4 * i + 2] = ALPHA_F * v[q][4 * i + 2] + gscale * g.z * bf2f((u16)(yv[q][i].y & 0xffff));
            v[q][4 * i + 3] = ALPHA_F * v[q][4 * i + 3] + gscale * g.w * bf2f((u16)(yv[q][i].y >> 16));
          }
        }
      } else {
#pragma unroll
        for (int q = 0; q < NRW; ++q)
#pragma unroll
          for (int i = 0; i < 16; ++i) v[q][i] *= ALPHA_F;
      }
      float mean[NRW], rstd[NRW];
#pragma unroll
      for (int q = 0; q < NRW; ++q) {
        float sum = 0.f;
#pragma unroll
        for (int i = 0; i < 16; ++i) sum += v[q][i];
        mean[q] = wave_sum(sum) * (1.f / DM);
        float sq = 0.f;
#pragma unroll
        for (int i = 0; i < 16; ++i) { const float d = v[q][i] - mean[q]; sq += d * d; }
        rstd[q] = rsqrtf(wave_sum(sq) * (1.f / DM) + LN_EPS);
      }
#pragma unroll
      for (int i = 0; i < 4; ++i) {
        const int col = i * 256 + lane * 4;
        const float4 g = *(const float4*)(lng + col);
        const float4 bb = *(const float4*)(lnb + col);
#pragma unroll
        for (int q = 0; q < NRW; ++q) {
          v[q][4 * i] = (v[q][4 * i] - mean[q]) * rstd[q] * g.x + bb.x;
          v[q][4 * i + 1] = (v[q][4 * i + 1] - mean[q]) * rstd[q] * g.y + bb.y;
          v[q][4 * i + 2] = (v[q][4 * i + 2] - mean[q]) * rstd[q] * g.z + bb.z;
          v[q][4 * i + 3] = (v[q][4 * i + 3] - mean[q]) * rstd[q] * g.w + bb.w;
          {
            typedef float f4s __attribute__((ext_vector_type(4)));
            const f4s xo = {v[q][4 * i], v[q][4 * i + 1], v[q][4 * i + 2], v[q][4 * i + 3]};
            __builtin_nontemporal_store(xo, (f4s*)(xd + q * DM + col));
          }
        }
      }
    }
    if (h) {
      float mean[NRW], rstd[NRW];
#pragma unroll
      for (int q = 0; q < NRW; ++q) {
        float sum = 0.f;
#pragma unroll
        for (int i = 0; i < 16; ++i) sum += v[q][i];
        mean[q] = wave_sum(sum) * (1.f / DM);
        float sq = 0.f;
#pragma unroll
        for (int i = 0; i < 16; ++i) { const float d = v[q][i] - mean[q]; sq += d * d; }
        rstd[q] = rsqrtf(wave_sum(sq) * (1.f / DM) + LN_EPS);
      }
      const float* sh = modN + (long)b * 9216 + si * 1024;
      const float* sc = modN + (long)b * 9216 + ci * 1024;
#pragma unroll
      for (int i = 0; i < 4; ++i) {
        const int col = i * 256 + lane * 4;
        const float4 s4 = *(const float4*)(sh + col);
        const float4 c4 = *(const float4*)(sc + col);
#pragma unroll
        for (int q = 0; q < NRW; ++q) {
          uint2 o;
          o.x = pack2bf((v[q][4 * i] - mean[q]) * rstd[q] * (1.f + c4.x) + s4.x, (v[q][4 * i + 1] - mean[q]) * rstd[q] * (1.f + c4.y) + s4.y);
          o.y = pack2bf((v[q][4 * i + 2] - mean[q]) * rstd[q] * (1.f + c4.z) + s4.z, (v[q][4 * i + 3] - mean[q]) * rstd[q] * (1.f + c4.w) + s4.w);
          *(uint2*)(h + ((long)(col >> 5) * NT + (rb + q)) * 32 + (col & 31)) = o;
        }
      }
    }
  }
}
__device__ __forceinline__ void fusew_job(int tidx_, int bidx_, char* smem, const float* __restrict__ w  , u16* dst) {
  float* t = (float*)smem;
  float* ct = t + 64 * 65;
  float* st = ct + 64;
  for (int u = bidx_; u < 128; u += gridDim.x) {
    const int g = u & 7, k0 = (u >> 3) * 64;
    for (int idx = tidx_; idx < 4096; idx += NTHR) {
      const int kk = idx >> 6, cc = idx & 63;
      t[kk * 65 + cc] = w[(long)(k0 + kk) * 2048 + g * 64 + cc];
    }
    if (tidx_ < 64) {
      float s, c;
      sincosf(6.283185307179586f * tidx_ / 64.f, &s, &c);
      ct[tidx_] = c;
      st[tidx_] = s;
    }
    __syncthreads();
    for (int idx = tidx_; idx < 1024; idx += NTHR) {
      const int which = idx >> 9, rem = idx & 511, cp = rem >> 3, cc = rem & 7;
      const float* tab = which ? st : ct;
      float o[8];
#pragma unroll
      for (int j = 0; j < 8; ++j) {
        const float* row = t + (cc * 8 + j) * 65;
        float a = 0.f;
        for (int c = 0; c < 64; ++c) a += row[c] * tab[(c * cp) & 63];
        o[j] = a;
      }
      uint4 v;
      v.x = pack2bf(o[0], o[1]); v.y = pack2bf(o[2], o[3]); v.z = pack2bf(o[4], o[5]); v.w = pack2bf(o[6], o[7]);
      *(uint4*)(dst + (long)(which * 512 + g * 64 + cp) * 32 + (long)((k0 + cc * 8) >> 5) * (2560 * 32) + ((k0 + cc * 8) & 31)) = v;
    }
    __syncthreads();
  }
}

__device__ __forceinline__ void dft_job(int tidx_, int bidx_, u16* DC, u16* DS) {
  for (int idx = bidx_ * NTHR + tidx_; idx < 2048 * 256; idx += gridDim.x * NTHR) {
    const int lp = idx >> 8, l0 = (idx & 255) * 8;
    float c[8], s[8];
#pragma unroll
    for (int j = 0; j < 8; ++j) {
      const int m = (lp * (l0 + j)) & 2047;
      sincosf((float)m * (6.283185307179586f / 2048.f), &s[j], &c[j]);
    }
    uint4 vc, vs;
    vc.x = pack2bf(c[0], c[1]); vc.y = pack2bf(c[2], c[3]); vc.z = pack2bf(c[4], c[5]); vc.w = pack2bf(c[6], c[7]);
    vs.x = pack2bf(-s[0], -s[1]); vs.y = pack2bf(-s[2], -s[3]); vs.z = pack2bf(-s[4], -s[5]); vs.w = pack2bf(-s[6], -s[7]);
    *(uint4*)(DC + (long)lp * 2048 + l0) = vc;
    *(uint4*)(DS + (long)lp * 2048 + l0) = vs;
  }
}

__device__ __forceinline__ void hd2_job(int tidx_, int bidx_, char* smem, const Params& p, float* HD2) {
  float* z = (float*)smem;
  float* h1 = z + 4 * 36;
  const int tid = tidx_;
  for (int u = bidx_; u < 576; u += gridDim.x) {
    if (tid < 132) {
      const int pp = tid / 33, i = tid % 33;
      const int P = u * 4 + pp;
      const int L = (P < 2048) ? 2048 : 256;
      const int pos = (P < 2048) ? P : P - 2048;
      float val;
      if (i == 0) val = (float)pos / (float)(L - 1);
      else {
        const int band = (i - 1) & 15;
        const float fr = 1e-4f + (float)band * ((15.f - 1e-4f) / 15.f);
        const float w = 6.283185307179586f * (float)pos * fr / (float)L;
        val = (i >= 17) ? -sinf(w) : cosf(w);
      }
      z[pp * 36 + i] = val;
    }
    __syncthreads();
    const int pp = tid >> 6, o = tid & 63;
    const float fq = p.hy_freq[o];
    float a = p.hy_b1[o];
    for (int i = 0; i < 33; ++i) a += z[pp * 36 + i] * p.hy_w1[i * 64 + o];
    h1[pp * 64 + o] = sinf(fq * a);
    __syncthreads();
    float a2 = p.hy_b2[o];
    for (int i = 0; i < 64; ++i) a2 += h1[pp * 64 + i] * p.hy_w2[i * 64 + o];
    HD2[(long)(u * 4 + pp) * 64 + o] = sinf(fq * a2);
    __syncthreads();
  }
}

__device__ __forceinline__ void fraw_job(int tidx_, int bidx_, char* smem, const Params& p, const float* HD2, float* FR) {
  float* w3s = (float*)smem;
  const int tid = tidx_;
  for (int u = bidx_; u < 288; u += gridDim.x) {
    const int lt = (u >= 256) ? 1 : 0;
    const int uu = lt ? u - 256 : u;
    const int L = lt ? 256 : 2048;
    const int pb = lt ? 0 : (uu >> 5), jb = uu & 31;
    const int pos = pb * 256 + tid;
    const long P = (lt ? 2048 : 0) + pos;
    float hd[64];
#pragma unroll
    for (int i = 0; i < 16; ++i) {
      const float4 v = *(const float4*)(HD2 + P * 64 + i * 4);
      hd[4 * i] = v.x; hd[4 * i + 1] = v.y; hd[4 * i + 2] = v.z; hd[4 * i + 3] = v.w;
    }
    for (int idx = tid; idx < 4096; idx += NTHR) w3s[idx] = p.hy_w3[(long)(idx >> 6) * 2048 + jb * 64 + (idx & 63)];
    __syncthreads();
    const float t = (float)pos / (float)(L - 1);
    float* out = FR + (lt ? (long)2048 * 2048 : 0);
    const float da = -3.0701134573253945f, db = -15.350567286626973f;
    for (int jj = 0; jj < 64; ++jj) {
      float a = 0.f;
#pragma unroll
      for (int i = 0; i < 64; ++i) a += hd[i] * w3s[i * 64 + jj];
      const int j = jb * 64 + jj, ch = j & 511;
      const float delta = fabsf(da + (db - da) * (float)ch / 511.f);
      out[(long)j * L + pos] = a * expf(-t * delta);
    }
    __syncthreads();
  }
}

__device__ __forceinline__ void sconv_job(int tidx_, int bidx_, const Params& p, const u16* __restrict__ U, u16* __restrict__ V) {
  const int per = NT / 8;
  for (long idx = (long)bidx_ * NTHR + tidx_; idx < (long)1536 * per; idx += (long)gridDim.x * NTHR) {
    const int j = (int)(idx / per), tok0 = (int)(idx % per) * 8;
    int ls, L;
    if (tok0 < NLAT) { ls = tok0 & 2047; L = 2048; } else { ls = (tok0 - NLAT) & 255; L = 256; }
    const u16* row = U + (long)j * NT;
    const uint4 cur = *(const uint4*)(row + tok0);
    float x[10];
    const u16 xl = row[max(tok0 - 1, 0)], xr = row[min(tok0 + 8, NT - 1)];
    x[0] = (ls > 0) ? bf2f(xl) : 0.f;
    x[9] = (ls + 8 < L) ? bf2f(xr) : 0.f;
    x[1] = bf2f((u16)(cur.x & 0xffff)); x[2] = bf2f((u16)(cur.x >> 16));
    x[3] = bf2f((u16)(cur.y & 0xffff)); x[4] = bf2f((u16)(cur.y >> 16));
    x[5] = bf2f((u16)(cur.z & 0xffff)); x[6] = bf2f((u16)(cur.z >> 16));
    x[7] = bf2f((u16)(cur.w & 0xffff)); x[8] = bf2f((u16)(cur.w >> 16));
    const float w0 = p.hy_conv_w[j], w1 = p.hy_conv_w[1536 + j], w2 = p.hy_conv_w[3072 + j], bb = p.hy_conv_b[j];
    float o[8];
#pragma unroll
    for (int i = 0; i < 8; ++i) o[i] = w0 * x[i] + w1 * x[i + 1] + w2 * x[i + 2] + bb;
    uint4 v;
    v.x = pack2bf(o[0], o[1]); v.y = pack2bf(o[2], o[3]); v.z = pack2bf(o[4], o[5]); v.w = pack2bf(o[6], o[7]);
    *(uint4*)(V + (long)j * NT + tok0) = v;
  }
}

template <int TT>
__device__ __forceinline__ void toep_unit(int tidx_, int bidx_, char* smem, const Params& p, int ch, int tokbase, const float* FRl, const u16* V, u16* z1row, u16* z2row) {
  constexpr int L = 128 * TT;
  constexpr int ES = (TT == 16) ? 4112 : 528;
  u16* E = (u16*)smem;
  float* red = (float*)(smem + 8 * ES * 2);
  const int tid = tidx_, lane = tid & 63, wid = tid >> 6;
  const int fr = lane & 15, fq = lane >> 4;
  const u16* vrow = V + (long)ch * NT;
  for (int o = 0; o < 2; ++o) {
    const u16* zsrc = o ? z1row : vrow;
    u16* zdst = o ? z2row : z1row;
    const float* fwd = FRl + (long)(o * 512 + ch) * L;
    const float* bwd = FRl + (long)(1024 + o * 512 + ch) * L;
    float s = 0.f;
    for (int i = tid; i < L; i += NTHR) {
      const float fb = fabsf(bwd[i]);
      s += fabsf(fwd[i]) + ((i > 0) ? fb : 0.f);
    }
    s = wave_sum(s);
    if (lane == 0) red[wid] = s;
    __syncthreads();
    const float scale = 1.f / (red[0] + red[1] + red[2] + red[3] + 1e-6f);
    for (int idx = tid; idx < 8 * ES; idx += NTHR) {
      const int rho = idx / ES, m = idx - rho * ES;
      const int dp = m - rho - L;
      const float vf = fwd[min(max(-dp, 0), L - 1)];
      const float vb = bwd[min(max(dp, 0), L - 1)];
      float v = (dp <= 0) ? vf : vb;
      if (dp <= -L || dp >= L) v = 0.f;
      E[idx] = f2bf(v * scale);
    }
    __syncthreads();
    const float skip = p.hy_skip[o * 512 + ch];
    const u16* xg = V + (long)(512 + o * 512 + ch) * NT;
    const u16* bsrc = zsrc + tokbase + fr * L + fq * 8;
#pragma unroll 1
    for (int s2 = 0; s2 < 2; ++s2) {
      f32x4 acc[TT];
#pragma unroll
      for (int t = 0; t < TT; ++t) acc[t] = f32x4{0.f, 0.f, 0.f, 0.f};
      const u16* e0 = E + (fr & 7) * ES + 8 * fq - 32 * wid - 16 * s2 - 8 * (fr >> 3) + L;
      bf16x8 cur[4], nxt[4];
#pragma unroll
      for (int i = 0; i < 4; ++i) { cur[i] = *(const bf16x8*)(bsrc + i * 32); nxt[i] = cur[i]; }
#pragma unroll 1
      for (int kb0 = 0; kb0 < L / 32; kb0 += 4) {
        if (kb0 + 4 < L / 32) {
#pragma unroll
          for (int i = 0; i < 4; ++i) nxt[i] = *(const bf16x8*)(bsrc + (kb0 + 4 + i) * 32);
        }
#pragma unroll
        for (int i = 0; i < 4; ++i) {
          bf16x8 af[TT];
#pragma unroll
          for (int t = 0; t < TT; ++t) af[t] = *(const bf16x8*)(e0 + 32 * (kb0 + i) - 128 * t);
          __builtin_amdgcn_sched_barrier(0);
#pragma unroll
          for (int t = 0; t < TT; ++t) acc[t] = __builtin_amdgcn_mfma_f32_16x16x32_bf16(af[t], cur[i], acc[t], 0, 0, 0);
          __builtin_amdgcn_sched_barrier(0);
        }
#pragma unroll
        for (int i = 0; i < 4; ++i) cur[i] = nxt[i];
      }
      uint2 zz[TT], xx[TT];
#pragma unroll
      for (int t = 0; t < TT; ++t) {
        const int tok = tokbase + fr * L + 128 * t + 32 * wid + 16 * s2 + fq * 4;
        zz[t] = *(const uint2*)(zsrc + tok);
        xx[t] = *(const uint2*)(xg + tok);
      }
#pragma unroll
      for (int t = 0; t < TT; ++t) {
        const int tok = tokbase + fr * L + 128 * t + 32 * wid + 16 * s2 + fq * 4;
        uint2 rr;
        rr.x = pack2bf(bf2f((u16)(xx[t].x & 0xffff)) * (acc[t][0] + bf2f((u16)(zz[t].x & 0xffff)) * skip),
                       bf2f((u16)(xx[t].x >> 16)) * (acc[t][1] + bf2f((u16)(zz[t].x >> 16)) * skip));
        rr.y = pack2bf(bf2f((u16)(xx[t].y & 0xffff)) * (acc[t][2] + bf2f((u16)(zz[t].y & 0xffff)) * skip),
                       bf2f((u16)(xx[t].y >> 16)) * (acc[t][3] + bf2f((u16)(zz[t].y >> 16)) * skip));
        *(uint2*)(zdst + tok) = rr;
      }
    }
    __syncthreads();
  }
}

__device__ __forceinline__ void ztrans_job(int tidx_, int bidx_, char* smem, const u16* __restrict__ Z2, u16* ymix) {
  u16* tl = (u16*)smem;
  const int ntt = NT / 64;
  for (int u = bidx_; u < 8 * ntt; u += gridDim.x) {
    const int cb = (u & 7) * 64, t0 = (u >> 3) * 64;
    for (int idx = tidx_; idx < 512; idx += NTHR) {
      const int c = idx >> 3, k = idx & 7;
      *(bf16x8*)(tl + c * 72 + k * 8) = *(const bf16x8*)(Z2 + (long)(cb + c) * NT + t0 + k * 8);
    }
    __syncthreads();
    for (int idx = tidx_; idx < 512; idx += NTHR) {
      const int tk = idx >> 3, k = idx & 7;
      bf16x8 v;
#pragma unroll
      for (int e = 0; e < 8; ++e) v[e] = (short)tl[(k * 8 + e) * 72 + tk];
      *(bf16x8*)(ymix + (long)(t0 + tk) * DM + 512 + cb + k * 8) = v;
    }
    __syncthreads();
  }
}

__device__ __forceinline__ void toep_job(int tidx_, int bidx_, char* smem, const Params& p, const float* FR, const u16* V, u16* Z1, u16* Z2) {
  for (int u = bidx_; u < 1024; u += gridDim.x) {
    if (u < 512) toep_unit<16>(tidx_, bidx_, smem, p, u, 0, FR, V, Z1 + (long)u * NT, Z2 + (long)u * NT);
    else toep_unit<2>(tidx_, bidx_, smem, p, u - 512, NLAT, FR + (long)2048 * 2048, V, Z1 + (long)(u - 512) * NT, Z2 + (long)(u - 512) * NT);
  }
}


__device__ __forceinline__ void lds_barrier() {
  asm volatile("s_waitcnt lgkmcnt(0)" ::: "memory");
  __builtin_amdgcn_s_barrier();
  asm volatile("" ::: "memory");
}

__device__ __forceinline__ int scan_row(bool hg, int step, int dir, int b, int j) {
  if (step < 4) {
    const int pc = step * 64 + j;
    return NLAT + b * 256 + (dir ? 255 - pc : pc);
  }
  const int pl = (step - 4) * 64 + j;
  const int sp = dir ? 2047 - pl : pl;
  const int l = hg ? ((sp & 31) * 64 + (sp >> 5)) : sp;
  return b * 2048 + l;
}

using f16x8 = __attribute__((ext_vector_type(8))) _Float16;

template <int DK, bool HG>
__device__ __forceinline__ void scan_unit(int tidx_, char* smem, const Params& p, const _Float16* __restrict__ PROJ, u16* Of, u16* Ob,
                                          const float* LB, int b, int head, int vs) {
  constexpr int PQ = DK + 8, PJ = 72, P = 256 / DK, TP = 64 / P, NDF = DK / 64, CPR = DK / 8;
  u16* QIN = (u16*)smem;
  u16* KIN = QIN + 64 * PQ;
  u16* KINT = KIN + 64 * PQ;
  u16* VT = KINT + DK * PJ;
  u16* ATT = VT + 32 * PJ;
  u16* ST = ATT + 64 * PJ;
  float* EGL = (float*)(ST + 32 * PQ);
  float* PS = EGL + DK;
  float* XG = PS + P * DK;
  _Float16* GRAW = (_Float16*)ATT;
  float* AF = (float*)ATT;
  _Float16* QH = (_Float16*)QIN;
  _Float16* KH = (_Float16*)KIN;
  const int lane = tidx_ & 63, wid = tidx_ >> 6, fr = lane & 15, fq = lane >> 4;
  const int cd = tidx_ % DK;
  const int qcol = HG ? 1568 + head * 128 : head * 64;
  const int kcol = 256 + head * 64;
  const int vcol = (HG ? 3104 : 512) + head * 128 + vs * 32;
  const int ocol = (HG ? 512 : 0) + head * 128 + vs * 32;
  const float lbv = HG ? LB[head * 128 + cd] : 0.f;
  for (int dir = 1; dir >= 0; --dir) {
    __syncthreads();
    const int gcol = HG ? (dir ? 2592 : 2080) + head * 128 : (dir ? 1552 : 1536);
    float aup[16];
    float abias = 0.f;
#pragma unroll
    for (int r = 0; r < 16; ++r) aup[r] = HG ? 0.f : p.gla_a_up[(dir * 16 + r) * 256 + head * 64 + (cd & 63)];
    if (!HG) abias = p.gla_a_b[dir * 256 + head * 64 + (cd & 63)];
    f32x4 S[NDF][2];
#pragma unroll
    for (int df = 0; df < NDF; ++df) { S[df][0] = f32x4{0.f, 0.f, 0.f, 0.f}; S[df][1] = f32x4{0.f, 0.f, 0.f, 0.f}; }
    constexpr int NIT = DK / 32;
    f16x8 rq[NIT], rk[NIT], rv, raf;
#define SCAN_LOAD(stp) do { \
      _Pragma("unroll") for (int it = 0; it < NIT; ++it) { \
        const int idx_ = tidx_ + it * NTHR; const int j_ = idx_ / CPR, c_ = idx_ % CPR; \
        const _Float16* rp_ = PROJ + (long)scan_row(HG, (stp), dir, b, j_) * 4128; \
        rq[it] = *(const f16x8*)(rp_ + qcol + c_ * 8); \
        rk[it] = *(const f16x8*)(rp_ + (HG ? gcol : kcol) + c_ * 8); \
      } \
      if (!HG) raf = *(const f16x8*)(PROJ + (long)scan_row(HG, (stp), dir, b, (tidx_ >> 1) & 63) * 4128 + gcol + (tidx_ & 1) * 8); \
      rv = *(const f16x8*)(PROJ + (long)scan_row(HG, (stp), dir, b, tidx_ >> 2) * 4128 + vcol + (tidx_ & 3) * 8); \
    } while (0)
    SCAN_LOAD(0);
#pragma unroll 1
    for (int step = 0; step < 36; ++step) {
      const bool isctx = step < 4;
#pragma unroll
      for (int it = 0; it < NIT; ++it) {
        const int idx = tidx_ + it * NTHR;
        const int j = idx / CPR, c = idx % CPR;
        *(f16x8*)(QH + j * PQ + c * 8) = rq[it];
        if (!HG) *(f16x8*)(KH + j * PQ + c * 8) = rk[it];
        else *(f16x8*)(GRAW + j * DK + c * 8) = rk[it];
      }
      if (!HG && tidx_ < 128) {
        const int j = tidx_ >> 1, c = tidx_ & 1;
#pragma unroll
        for (int e = 0; e < 8; ++e) AF[j * 16 + c * 8 + e] = (float)raf[e];
      }
      {
        const int j = tidx_ >> 2, c = tidx_ & 3;
#pragma unroll
        for (int e = 0; e < 8; ++e) VT[(c * 8 + e) * PJ + j] = f2bf((float)rv[e]);
      }
      if (step + 1 < 36) SCAN_LOAD(step + 1);
      lds_barrier();
      if (!HG) {
        const int c2 = tidx_ & 63, jq = tidx_ >> 6;
#pragma unroll 4
        for (int jj = 0; jj < 16; ++jj) {
          const int j = jq * 16 + jj;
          float x = abias;
#pragma unroll
          for (int r4 = 0; r4 < 4; ++r4) {
            const float4 a4 = *(const float4*)(AF + j * 16 + r4 * 4);
            x += a4.x * aup[4 * r4] + a4.y * aup[4 * r4 + 1] + a4.z * aup[4 * r4 + 2] + a4.w * aup[4 * r4 + 3];
          }
          const float g = (fminf(x, 0.f) - __logf(1.f + __expf(-fabsf(x)))) * (1.f / 16.f);
          XG[j * DK + c2] = __expf(g);
        }
        lds_barrier();
      }
      const int tb = HG ? tidx_ : tidx_ - ((vs & 1) ? 128 : 0);
      const int part = tb / DK;
      if (HG || (tb >= 0 && tb < 128)) {
        float pr = 1.f;
#pragma unroll 8
        for (int jj = 0; jj < 32; ++jj) {
          const int j = part ? 32 + jj : 31 - jj;
          const float qv = (float)QH[j * PQ + cd];
          float gf, kv;
          if (HG) {
            const float x = (float)GRAW[j * DK + cd];
            gf = lbv + (1.f - lbv) * __builtin_amdgcn_rcpf(1.f + __expf(-x));
            kv = 1.f - gf;
          } else {
            gf = XG[j * DK + cd];
            kv = (float)KH[j * PQ + cd];
          }
          const float nx = pr * gf;
          const float use = part ? nx : pr;
          const float oth = __builtin_amdgcn_rcpf(use);
          const float eg = part ? use : oth;
          const float eng = part ? oth : use;
          pr = nx;
          unsigned pk;
          asm("v_cvt_pk_bf16_f32 %0, %1, %2" : "=v"(pk) : "v"(qv * eg * (HG ? 1.f : 0.125f)), "v"(kv * eng));
          const u16 kb = (u16)(pk >> 16);
          QIN[j * PQ + cd] = (u16)(pk & 0xffffu);
          KIN[j * PQ + cd] = kb;
          KINT[cd * PJ + j] = kb;
        }
        if (part) EGL[cd] = pr;
        else PS[cd] = pr;
      }
      lds_barrier();
      if (!isctx) {
        f32x4 at[4];
#pragma unroll
        for (int jf = 0; jf < 4; ++jf) at[jf] = f32x4{0.f, 0.f, 0.f, 0.f};
#pragma unroll
        for (int ks = 0; ks < DK / 32; ++ks) {
          const bf16x8 a = *(const bf16x8*)(QIN + (wid * 16 + fr) * PQ + ks * 32 + fq * 8);
#pragma unroll
          for (int jf = 0; jf < 4; ++jf)
            if (jf <= wid) {
              const bf16x8 bb = *(const bf16x8*)(KIN + (jf * 16 + fr) * PQ + ks * 32 + fq * 8);
              at[jf] = __builtin_amdgcn_mfma_f32_16x16x32_bf16(a, bb, at[jf], 0, 0, 0);
            }
        }
#pragma unroll
        for (int jf = 0; jf < 4; ++jf)
#pragma unroll
          for (int rg = 0; rg < 4; ++rg) {
            const int i = wid * 16 + fq * 4 + rg, j = jf * 16 + fr;
            ATT[i * PJ + j] = f2bf((j <= i) ? at[jf][rg] : 0.f);
          }
#pragma unroll
        for (int df = 0; df < NDF; ++df)
#pragma unroll
          for (int vf = 0; vf < 2; ++vf) {
            const float* ec = PS + (wid + 4 * df) * 16 + fq * 4;
            uint2 pk;
            pk.x = pack2bf(ec[0] * S[df][vf][0], ec[1] * S[df][vf][1]);
            pk.y = pack2bf(ec[2] * S[df][vf][2], ec[3] * S[df][vf][3]);
            *(uint2*)(ST + (vf * 16 + fr) * PQ + (wid + 4 * df) * 16 + fq * 4) = pk;
          }
      }
      lds_barrier();
      if (!isctx) {
        f32x4 oa[2];
        oa[0] = f32x4{0.f, 0.f, 0.f, 0.f};
        oa[1] = f32x4{0.f, 0.f, 0.f, 0.f};
#pragma unroll
        for (int ks = 0; ks < 2; ++ks) {
          const bf16x8 a = *(const bf16x8*)(ATT + (wid * 16 + fr) * PJ + ks * 32 + fq * 8);
#pragma unroll
          for (int vf = 0; vf < 2; ++vf) {
            const bf16x8 bb = *(const bf16x8*)(VT + (vf * 16 + fr) * PJ + ks * 32 + fq * 8);
            oa[vf] = __builtin_amdgcn_mfma_f32_16x16x32_bf16(a, bb, oa[vf], 0, 0, 0);
          }
        }
#pragma unroll
        for (int ks = 0; ks < DK / 32; ++ks) {
          const bf16x8 a = *(const bf16x8*)(QIN + (wid * 16 + fr) * PQ + ks * 32 + fq * 8);
#pragma unroll
          for (int vf = 0; vf < 2; ++vf) {
            const bf16x8 bb = *(const bf16x8*)(ST + (vf * 16 + fr) * PQ + ks * 32 + fq * 8);
            oa[vf] = __builtin_amdgcn_mfma_f32_16x16x32_bf16(a, bb, oa[vf], 0, 0, 0);
          }
        }
#pragma unroll
        for (int rg = 0; rg < 4; ++rg) {
          const long row = scan_row(HG, step, dir, b, wid * 16 + fq * 4 + rg);
#pragma unroll
          for (int vf = 0; vf < 2; ++vf) {
            (dir ? Ob : Of)[row * DM + ocol + vf * 16 + fr] = f2bf(oa[vf][rg]);
          }
        }
      }
#pragma unroll
      for (int df = 0; df < NDF; ++df)
#pragma unroll
        for (int vf = 0; vf < 2; ++vf) {
          f32x4 u = f32x4{0.f, 0.f, 0.f, 0.f};
#pragma unroll
          for (int ks = 0; ks < 2; ++ks) {
            const bf16x8 a = *(const bf16x8*)(KINT + ((wid + 4 * df) * 16 + fr) * PJ + ks * 32 + fq * 8);
            const bf16x8 bb = *(const bf16x8*)(VT + (vf * 16 + fr) * PJ + ks * 32 + fq * 8);
            u = __builtin_amdgcn_mfma_f32_16x16x32_bf16(a, bb, u, 0, 0, 0);
          }
#pragma unroll
          for (int rg = 0; rg < 4; ++rg) {
            const int dd = (wid + 4 * df) * 16 + fq * 4 + rg;
            S[df][vf][rg] = EGL[dd] * (PS[dd] * S[df][vf][rg] + u[rg]);
          }
        }
      lds_barrier();
    }
  }
}

#undef SCAN_LOAD
__device__ __forceinline__ void scan_job(int tidx_, int bidx_, char* smem, const Params& p, const _Float16* PROJ, u16* Of, u16* Ob, const float* LB) {
  for (int u = bidx_; u < 512; u += gridDim.x) {
    const int hg = u & 1, r = u >> 1;
    const int b = r >> 4, head = (r >> 2) & 3, vs = r & 3;
    if (hg) scan_unit<128, true>(tidx_, smem, p, PROJ, Of, Ob, LB, b, head, vs);
    else scan_unit<64, false>(tidx_, smem, p, PROJ, Of, Ob, LB, b, head, vs);
  }
}

__device__ __forceinline__ void readout_job(int tidx_, int bidx_, const Params& p, const _Float16* __restrict__ PROJ, const u16* __restrict__ O, u16* ymix) {
  const int lane = tidx_ & 63, wid = tidx_ >> 6;
  const int grp = lane >> 3, c0 = (lane & 7) * 16;
  const bool ishg = grp >= 4;
  const float* gw = ishg ? p.hg_norm_g : p.gla_norm_g;
  for (int r = bidx_ * 4 + wid; r < NLAT; r += gridDim.x * 4) {
    const int col = grp * 128 + c0;
    const int gatecol = ishg ? 3616 + (grp - 4) * 128 + c0 : 1024 + grp * 128 + c0;
    float v[16], mul[16];
    float ss = 0.f;
#pragma unroll
    for (int h2 = 0; h2 < 2; ++h2) {
      const bf16x8 ov = *(const bf16x8*)(O + (long)r * DM + col + h2 * 8);
      const bf16x8 ow = *(const bf16x8*)(ymix + (long)r * DM + col + h2 * 8);
      const f16x8 gv = *(const f16x8*)(PROJ + (long)r * 4128 + gatecol + h2 * 8);
#pragma unroll
      for (int e = 0; e < 8; ++e) {
        const float o = bf2f((u16)ov[e]) + bf2f((u16)ow[e]);
        const float g = (float)gv[e];
        const float sg = __builtin_amdgcn_rcpf(1.f + __expf(-g));
        const float t = ishg ? o * sg : o;
        v[h2 * 8 + e] = t;
        mul[h2 * 8 + e] = ishg ? 1.f : g * sg;
        ss += t * t;
      }
    }
    ss += __shfl_xor(ss, 1);
    ss += __shfl_xor(ss, 2);
    ss += __shfl_xor(ss, 4);
    const float rinv = rsqrtf(ss * (1.f / 128.f) + LN_EPS);
    unsigned pk[8];
#pragma unroll
    for (int e = 0; e < 8; ++e)
      pk[e] = pack2bf(v[2 * e] * rinv * gw[c0 + 2 * e] * mul[2 * e], v[2 * e + 1] * rinv * gw[c0 + 2 * e + 1] * mul[2 * e + 1]);
    *(uint4*)(ymix + (long)r * DM + col) = uint4{pk[0], pk[1], pk[2], pk[3]};
    *(uint4*)(ymix + (long)r * DM + col + 8) = uint4{pk[4], pk[5], pk[6], pk[7]};
  }
}

#define FFN_G1(woff, rows) do { kind = K_GEMM; g.A0 = H; g.B0 = (const u16*)(ws + (woff)); g.Mt = (rows) / 128; g.Ntl = 22; g.wide = 1; g.ars = 32; g.aks = (long)NT * 32; g.brs = 32; g.bks = (long)5632 * 32; g.epi = EPI_SWIGLU; g.C = H1; g.ldc = DFF; } while (0)
#define FFN_G2(woff, rows) do { kind = K_GEMM; g.A0 = H1; g.lda = DFF; g.B0 = (const u16*)(ws + (woff)); g.ldb = DFF; g.K = DFF; g.Mt = (rows) / 128; g.Ntl = 4; g.wide = 1; \
      g.ars = 32; g.aks = (long)NT * 32; g.brs = 32; g.bks = (long)1024 * 32; g.epi = EPI_BF16; g.C = Y; } while (0)
#define ROWD(xsl, xsc, yy, modl, gi_, gs_, lnidx, layer, modn, si_, ci_, hh, rows) do { kind = K_ROW; r.xs_lat = (xsl); r.xs_ctx = (xsc); r.y = (yy); r.modL = (modl); r.gi = (gi_); \
      r.gscale = (gs_); r.lng = p.ln_g + ((layer) * 3 + (lnidx)) * DM; r.lnb = p.ln_b + ((layer) * 3 + (lnidx)) * DM; r.modN = (modn); r.si = (si_); r.ci = (ci_); r.h = (hh); r.nrows = (rows); } while (0)
enum { K_NONE = 0, K_PREP0, K_PREP1, K_GEMM, K_ROW, K_SCONV, K_EVMIX, K_SCAN, K_READOUT, K_ZTRANS };

struct RowD {
  const float *xs_lat, *xs_ctx;
  const u16* y;
  const float *modL, *lng, *lnb, *modN;
  u16* h;
  int gi, si, ci, nrows;
  float gscale;
};

__global__ void __launch_bounds__(NTHR, 2) fwd_megakernel(Params p) {
  extern __shared__ __attribute__((aligned(16))) char smem[];
  cg::grid_group grid = cg::this_grid();
  char* ws = p.ws;
  float* modv = (float*)(ws + OFF_MOD);
  float* XC = (float*)(ws + OFF_XC);
  u16* H = (u16*)(ws + OFF_H);
  u16* H1 = (u16*)(ws + OFF_H1);
  u16* Y = (u16*)(ws + OFF_Y);
  u16* T = (u16*)(ws + OFF_T);
  u16* V = (u16*)(ws + OFF_V);
  u16* YE = (u16*)(ws + OFF_YE);
  u16* DC = (u16*)(ws + OFF_DC);
  u16* DS = (u16*)(ws + OFF_DS);
  float* HD2 = (float*)(ws + OFF_HD2);
  float* FR = (float*)(ws + OFF_FR);
  _Float16* PROJ = (_Float16*)(ws + OFF_PROJ);
  u16* OB = (u16*)(ws + OFF_O);
  u16* YO = (u16*)(ws + OFF_YO);
  const float* mod0 = modv;
  const float* mod1 = modv + (long)17 * 9216;

  int dup_done = 0;
  volatile LAS unsigned* xb_st = (volatile LAS unsigned*)(smem + LDS_BYTES - 16);
  if (threadIdx.x == 0) { xb_st[0] = 0u; xb_st[1] = 0u; }
  __syncthreads();
  const XcdBarrier xb = xcd_barrier_post((unsigned*)(ws + OFF_BAR), xb_st);
  for (int ph = 0; ph < NPHASE; ++ph) {
    int tidx_ = __builtin_amdgcn_workitem_id_x(), bidx_ = __builtin_amdgcn_workgroup_id_x();
    asm volatile("" : "+v"(tidx_));
    asm volatile("" : "+s"(bidx_));
    int kind = K_NONE;
    GemmD g{};
    RowD r{};
    g.nseg = 1; g.nbatch = 1; g.scale = 1.f; g.lda = DM; g.ldb = DM; g.K = DM; g.ldc = DM;
    switch (ph) {
      case 0: kind = K_PREP0; break;
      case 1: kind = K_PREP1; break;
      case 2: FFN_G1(OFF_W0_FFN_IN0, NT); break;
      case 3: FFN_G2(OFF_W0_FFN_OUT0, NT); break;
      case 4: ROWD(p.x, p.ctx, Y, mod0, 2, 0.5f, 0, 0, mod0, 3, 4, H, NT); break;
      case 5:
        kind = K_GEMM; g.A0 = H; g.B0 = (const u16*)(ws + OFF_W0_EV_IN); g.Mt = NT / 128; g.Ntl = 10; g.wide = 1; g.ars = 32; g.aks = (long)NT * 32; g.brs = 32; g.bks = (long)2560 * 32; g.epi = EPI_BF16_T; g.C = T; g.ldc = NT;
        break;
      case 6: kind = K_SCONV; break;
      case 7: kind = K_EVMIX; break;
      case 8: kind = K_ZTRANS; break;
      case 9:
        kind = K_GEMM; g.A0 = H; g.B0 = (const u16*)(ws + OFF_W0_EV_OUT); g.Mt = NT / 128; g.Ntl = 8; g.epi = EPI_BF16; g.C = YE;
        break;
      case 10: ROWD(p.out, XC, YE, mod0, 5, 1.f, 1, 0, mod0, 6, 7, H, NT); break;
      case 11: FFN_G1(OFF_W0_FFN_IN1, NT); break;
      case 12: FFN_G2(OFF_W0_FFN_OUT1, NT); break;
      case 13: ROWD(p.out, XC, Y, mod0, 8, 0.5f, 2, 0, mod1, 0, 1, H, NT); break;
      case 14: FFN_G1(OFF_W1_FFN_IN0, NT); break;
      case 15: FFN_G2(OFF_W1_FFN_OUT0, NT); break;
      case 16: ROWD(p.out, XC, Y, mod1, 2, 0.5f, 0, 1, mod1, 3, 4, H, NT); break;
      case 17:
        kind = K_GEMM; g.A0 = H; g.B0 = (const u16*)(ws + OFF_W1_OD_IN); g.Mt = NT / 128; g.Ntl = 17; g.wide = 1; g.ars = 32; g.aks = (long)NT * 32; g.brs = 32; g.bks = (long)4352 * 32; g.epi = EPI_F16; g.C = PROJ; g.ldc = 4128; g.ncols = 4128;
        break;
      case 18: kind = K_SCAN; break;
      case 19: kind = K_READOUT; break;
      case 20:
        kind = K_GEMM; g.A0 = H; g.B0 = (const u16*)(ws + OFF_W1_OD_OUT); g.Mt = NLAT / 128; g.Ntl = 8; g.epi = EPI_BF16; g.C = YO;
        break;
      case 21: ROWD(p.out, XC, YO, mod1, 5, 1.f, 1, 1, mod1, 6, 7, H, NLAT); break;
      case 22: FFN_G1(OFF_W1_FFN_IN1, NLAT); break;
      case 23: FFN_G2(OFF_W1_FFN_OUT1, NLAT); break;
      case 24: ROWD(p.out, XC, Y, mod1, 8, 0.5f, 2, 1, mod1, 0, 1, nullptr, NLAT); break;
      default: break;
    }
    switch (kind) {
      case K_PREP0: {
        mod_gemv(tidx_, bidx_, smem, p, modv);
        for (int ls = 0; ls < 4; ++ls) {
          const size_t io = (ls == 0) ? OFF_W0_FFN_IN0 : (ls == 1) ? OFF_W0_FFN_IN1 : (ls == 2) ? OFF_W1_FFN_IN0 : OFF_W1_FFN_IN1;
          const size_t oo = (ls == 0) ? OFF_W0_FFN_OUT0 : (ls == 1) ? OFF_W0_FFN_OUT1 : (ls == 2) ? OFF_W1_FFN_OUT0 : OFF_W1_FFN_OUT1;
          convert_job(tidx_, bidx_, smem, p.ffn_w_in + (long)ls * 1024 * 5632, 5632, 1024, 5632, 5632, (u16*)(ws + io), 1, 32, (long)5632 * 32);
          convert_job(tidx_, bidx_, smem, p.ffn_w_out + (long)ls * DFF * 1024, 1024, DFF, 1024, 1024, (u16*)(ws + oo), 0, 32, (long)1024 * 32);
        }
        for (int jb = 0; jb < 4; ++jb) {
          const float* src = (jb == 0) ? p.ev_w_in + 512 : (jb == 1) ? p.ev_w_out : (jb == 2) ? p.od_w_in : p.od_w_out;
          const int pitch = (jb == 0) ? 2048 : (jb == 2) ? 4128 : 1024;
          const int nsrc = (jb == 0) ? 1536 : (jb == 2) ? 4128 : 1024;
          const int nout = (jb == 0) ? 1536 : (jb == 2) ? 4352 : 1024;
          u16* dst = (u16*)(ws + ((jb == 0) ? OFF_W0_EV_IN + (size_t)1024 * 32 * 2 : (jb == 1) ? OFF_W0_EV_OUT : (jb == 2) ? OFF_W1_OD_IN : OFF_W1_OD_OUT));
          const long brs = (jb == 0 || jb == 2) ? 32 : 1024;
          const long bks = (jb == 0) ? (long)2560 * 32 : (jb == 2) ? (long)4352 * 32 : 32;
          convert_job(tidx_, bidx_, smem, src, pitch, 1024, nsrc, nout, dst, 0, brs, bks);
        }
        fusew_job(tidx_, bidx_, smem, p.ev_w_in, (u16*)(ws + OFF_W0_EV_IN));
        dft_job(tidx_, bidx_, DC, DS);
        hd2_job(tidx_, bidx_, smem, p, HD2);
        if (bidx_ == 0) {
          float* lb = (float*)(ws + OFF_LB);
          for (int c2 = tidx_; c2 < 512; c2 += NTHR) lb[c2] = 1.f / (1.f + expf(p.hg_lb[c2] - p.hg_lb[512 + c2]));
        }
      } break;
      case K_PREP1: {
        rowpass(tidx_, bidx_, p.x, p.ctx, nullptr, nullptr, false, nullptr, nullptr, 0, 0.f, nullptr, nullptr, mod0, 0, 1, H, NT);
        fraw_job(tidx_, bidx_, smem, p, HD2, FR);
      } break;
      case K_GEMM: gemm_job(tidx_, bidx_, smem, g); break;
      case K_ROW:
        rowpass(tidx_, bidx_, r.xs_lat, r.xs_ctx, p.out, XC, true, r.y, r.modL, r.gi, r.gscale, r.lng, r.lnb, r.modN, r.si, r.ci, r.h, r.nrows);
        break;
      case K_SCAN: scan_job(tidx_, bidx_, smem, p, PROJ, OB, H, (const float*)(ws + OFF_LB)); break;
      case K_READOUT: readout_job(tidx_, bidx_, p, PROJ, OB, H); break;
      case K_ZTRANS: ztrans_job(tidx_, bidx_, smem, T + (long)1536 * NT, H); break;
      case K_SCONV: sconv_job(tidx_, bidx_, p, T + (long)1024 * NT, V); break;
      case K_EVMIX: {
        toep_job(tidx_, bidx_, smem, p, FR, V, T + (long)1024 * NT, T + (long)1536 * NT);
        GemmD f{};
        f.A0 = DC; f.A1 = DS; f.lda = 2048; f.B0 = T; f.B1 = T + (long)512 * NT; f.ldb = NT; f.bsB = 2048; f.K = 2048; f.nseg = 2;
        f.Mt = 16; f.Ntl = 2; f.wide = 1; f.nbatch = 16; f.bsCrow = 2048; f.crow0 = 0; f.epi = EPI_BF16; f.C = H; f.ldc = DM; f.scale = 0.0027621358640099515f;
        gemm_job(tidx_, bidx_, smem, f);
        f.lda = 8 * 2048; f.B0 = T + NLAT; f.B1 = T + (long)512 * NT + NLAT; f.bsB = 256; f.K = 256; f.Mt = 2; f.bsCrow = 256; f.crow0 = NLAT;
        f.scale = 0.0078125f;
        gemm_job(tidx_, bidx_, smem, f);
      } break;
      default: break;
    }
    if (ph + 1 < NPHASE) {
      if (ph == 0) grid.sync();
      else xcd_barrier(xb);
    }
    if ((((DUPMASK >> kind) & 1) || ph == DUPPH) && dup_done != ph + 1) { dup_done = ph + 1; --ph; }
  }
}

extern "C" void kernel_launch(void* const* d_in, const int* in_sizes, int n_in, void* d_out, int out_size, void* d_ws,
                              size_t ws_size, hipStream_t stream) {
  static int grid_blocks = 0;
  if (!grid_blocks) {
    int dev = 0, cus = 0, per_cu = 0;
    (void)hipGetDevice(&dev);
    (void)hipDeviceGetAttribute(&cus, hipDeviceAttributeMultiprocessorCount, dev);
    (void)hipFuncSetAttribute((const void*)fwd_megakernel, hipFuncAttributeMaxDynamicSharedMemorySize, LDS_BYTES);
    (void)hipOccupancyMaxActiveBlocksPerMultiprocessor(&per_cu, (const void*)fwd_megakernel, NTHR, LDS_BYTES);
    if (per_cu < 1) per_cu = 1;
    if (per_cu > 2) per_cu = 2;
    grid_blocks = cus * per_cu;
    if (ws_size < WS_NEED) fprintf(stderr, "workspace too small: %zu < %zu\n", ws_size, (size_t)WS_NEED);
  }
  (void)hipMemsetAsync((char*)d_ws + OFF_BAR, 0, 16384, stream);
  Params p{};
  const float** pp = (const float**)&p;
  for (int i = 0; i < 28; ++i) pp[i] = (const float*)d_in[i];
  p.out = (float*)d_out;
  p.ws = (char*)d_ws;
  void* args[] = {&p};
  hipError_t e = hipLaunchCooperativeKernel((const void*)fwd_megakernel, dim3(grid_blocks), dim3(NTHR), args, LDS_BYTES, stream);
  if (e != hipSuccess) fprintf(stderr, "cooperative launch failed: %s (grid %d)\n", hipGetErrorString(e), grid_blocks);
}
```

```cpp
#include <hip/hip_runtime.h>
#include <hip/hip_cooperative_groups.h>
#include <cstdio>
namespace cg = cooperative_groups;

typedef unsigned short u16;
using bf16x8 = __attribute__((ext_vector_type(8))) short;
using f32x4 = __attribute__((ext_vector_type(4))) float;

#define NT 36864
#define NLAT 32768
#define DM 1024
#define DFF 2816
#define NTHR 256
#define LDS_BYTES 79872
#define ALPHA_F 1.4142135623730951f
#define LN_EPS 1e-6f
#define NPHASE 25
#define DUPPH (-1)
#define DUPMASK 0

constexpr size_t SZ_FFN_IN = (size_t)5632 * 1024 * 2;
constexpr size_t SZ_FFN_OUT = (size_t)1024 * 2816 * 2;
constexpr size_t OFF_W1_FFN_IN0 = 0;
constexpr size_t OFF_W1_FFN_IN1 = OFF_W1_FFN_IN0 + SZ_FFN_IN;
constexpr size_t OFF_W1_FFN_OUT0 = OFF_W1_FFN_IN1 + SZ_FFN_IN;
constexpr size_t OFF_W1_FFN_OUT1 = OFF_W1_FFN_OUT0 + SZ_FFN_OUT;
constexpr size_t OFF_W1_OD_IN = OFF_W1_FFN_OUT1 + SZ_FFN_OUT;
constexpr size_t OFF_W1_OD_OUT = OFF_W1_OD_IN + (size_t)4352 * 1024 * 2;
constexpr size_t OFF_MOD = OFF_W1_OD_OUT + (size_t)1024 * 1024 * 2;
constexpr size_t OFF_LB = OFF_MOD + (size_t)2 * 17 * 9216 * 4;
constexpr size_t OFF_BAR = OFF_LB + 2048;
constexpr size_t OFF_XC = OFF_BAR + 16384;
constexpr size_t OFF_H = OFF_XC + (size_t)4096 * 1024 * 4;
constexpr size_t OFF_W0_FFN_IN0 = OFF_H + (size_t)NT * 1024 * 2;
constexpr size_t OFF_W0_FFN_IN1 = OFF_W0_FFN_IN0 + SZ_FFN_IN;
constexpr size_t OFF_W0_FFN_OUT0 = OFF_W0_FFN_IN1 + SZ_FFN_IN;
constexpr size_t OFF_W0_FFN_OUT1 = OFF_W0_FFN_OUT0 + SZ_FFN_OUT;
constexpr size_t OFF_W0_EV_IN = OFF_W0_FFN_OUT1 + SZ_FFN_OUT;
constexpr size_t OFF_W0_EV_OUT = OFF_W0_EV_IN + (size_t)2560 * 1024 * 2;
constexpr size_t OFF_DC = OFF_W0_EV_OUT + (size_t)1024 * 1024 * 2;
constexpr size_t OFF_DS = OFF_DC + (size_t)2048 * 2048 * 2;
constexpr size_t OFF_HD2 = OFF_DS + (size_t)2048 * 2048 * 2;
constexpr size_t OFF_FR = OFF_HD2 + (size_t)2304 * 64 * 4;
constexpr size_t OFF_S = OFF_FR + (size_t)(2048 * 2048 + 2048 * 256) * 4;
constexpr size_t OFF_H1 = OFF_S;
constexpr size_t OFF_Y = OFF_H1 + (size_t)NT * DFF * 2;

constexpr size_t OFF_T = OFF_S;
constexpr size_t OFF_V = OFF_T + (size_t)2560 * NT * 2;
constexpr size_t OFF_YE = OFF_T + (size_t)1024 * NT * 2;
constexpr size_t OFF_PROJ = OFF_W0_FFN_IN0;
constexpr size_t OFF_O = OFF_PROJ + (size_t)NT * 4128 * 2;
constexpr size_t OFF_YO = OFF_PROJ;
constexpr size_t WS_NEED = OFF_V + (size_t)1536 * NT * 2;
static_assert(OFF_O + (size_t)NLAT * 1024 * 2 <= (size_t)512 * 1024 * 1024 && WS_NEED <= (size_t)512 * 1024 * 1024, "workspace");

struct Params {
  const float *x, *c, *ctx, *c_ctx, *mod_w, *mod_b, *ffn_w_in, *ffn_w_out, *ln_g, *ln_b,
      *ev_w_in, *ev_w_out, *hy_conv_w, *hy_conv_b, *hy_w1, *hy_b1, *hy_w2, *hy_b2, *hy_w3, *hy_freq, *hy_skip,
      *od_w_in, *od_w_out, *gla_a_up, *gla_a_b, *gla_norm_g, *hg_lb, *hg_norm_g;
  float* out;
  char* ws;
};

__device__ __forceinline__ u16 f2bf(float f) {
  unsigned u = __float_as_uint(f);
  u += 0x7fffu + ((u >> 16) & 1u);
  return (u16)(u >> 16);
}
__device__ __forceinline__ float bf2f(u16 h) { return __uint_as_float(((unsigned)h) << 16); }
__device__ __forceinline__ unsigned pack2bf(float a, float b) { return (unsigned)f2bf(a) | ((unsigned)f2bf(b) << 16); }
__device__ __forceinline__ float wave_sum(float v) {
#pragma unroll
  for (int o = 32; o > 0; o >>= 1) v += __shfl_xor(v, o);
  return v;
}

#define XB_TMO      128
#define XB_XCNT(j)  (256  + 64 * (j))
#define XB_XSUB(j)  (1280 + 64 * (j))
#define XB_XGEN(j)  (2304 + 64 * (j))
#define XB_TOP      3328
#define XB_TOPGEN   3392
#define XCD_BAR_WORDS 3456
#define XB_SPIN_CAP (1u << 18)
#define LAS __attribute__((address_space(3)))

__device__ __forceinline__ unsigned xb_ld(unsigned* p)              { return __hip_atomic_load(p, __ATOMIC_RELAXED, __HIP_MEMORY_SCOPE_AGENT); }
__device__ __forceinline__ unsigned xb_add(unsigned* p, unsigned v) { return __hip_atomic_fetch_add(p, v, __ATOMIC_RELAXED, __HIP_MEMORY_SCOPE_AGENT); }
__device__ __forceinline__ unsigned xb_xcc_id() { return (unsigned)__builtin_amdgcn_s_getreg((3 << 11) | 20) & 0xFu; }
#define XB_SPIN(cond, bar) do { unsigned _sp = 0; while (cond) { __builtin_amdgcn_s_sleep(1); \
    if ((++_sp & 255u) == 0u) { if (xb_ld(&(bar)[XB_TMO])) break; if (_sp > XB_SPIN_CAP) { atomicAdd(&(bar)[XB_TMO], 1u); break; } } } } while (0)

struct XcdBarrier {
    unsigned* bar; unsigned x;
    volatile LAS unsigned* st;
};

__device__ __forceinline__ XcdBarrier xcd_barrier_post(unsigned* bar, volatile LAS unsigned* st) {
    XcdBarrier b; b.bar = bar; b.x = xb_xcc_id(); b.st = st;
    if (threadIdx.x == 0) (void)xb_add(&bar[XB_XCNT(b.x)], 1u);
    return b;
}
__device__ __forceinline__ void xcd_barrier_complete(unsigned* bar, unsigned x, unsigned& nloc, unsigned& nx) {
    const unsigned G = gridDim.x * gridDim.y * gridDim.z;
    unsigned sum, cnt, mine, sp = 0u;
    for (;;) {
        sum = 0u; cnt = 0u; mine = 0u;
#pragma unroll
        for (unsigned j = 0; j < 16; ++j) { const unsigned c = xb_ld(&bar[XB_XCNT(j)]); sum += c; cnt += (c > 0u) ? 1u : 0u; mine = (j == x) ? c : mine; }
        if (sum == G) break;
        __builtin_amdgcn_s_sleep(1);
        if ((++sp & 255u) == 0u) { if (xb_ld(&bar[XB_TMO])) break; if (sp > XB_SPIN_CAP) { atomicAdd(&bar[XB_TMO], 1u); break; } }
    }
    nloc = mine > 0u ? mine : 1u; nx = cnt > 0u ? cnt : 1u;
}

__device__ __forceinline__ void xcd_barrier(const XcdBarrier& b) {
    asm volatile("s_waitcnt vmcnt(0)" ::: "memory");
    __syncthreads();
    if (threadIdx.x == 0) {
        unsigned* bar = b.bar;
        __builtin_amdgcn_s_waitcnt(0);
        unsigned nloc = b.st[0], nx = b.st[1];
        if (nloc == 0u) { xcd_barrier_complete(bar, b.x, nloc, nx); b.st[0] = nloc; b.st[1] = nx; }
        const unsigned old = xb_add(&bar[XB_XSUB(b.x)], 1u);
        const unsigned gen = old / nloc;
        if (old + 1u == (gen + 1u) * nloc) {
            __builtin_amdgcn_fence(__ATOMIC_RELEASE, "agent");
            asm volatile("s_waitcnt vmcnt(0)" ::: "memory");
            const unsigned og = xb_add(&bar[XB_TOP], 1u);
            const unsigned tg = og / nx;
            if (og + 1u == (tg + 1u) * nx) xb_add(&bar[XB_TOPGEN], 1u);
            else XB_SPIN(xb_ld(&bar[XB_TOPGEN]) == tg, bar);
            __builtin_amdgcn_fence(__ATOMIC_ACQUIRE, "agent");
            xb_add(&bar[XB_XGEN(b.x)], 1u);
            asm volatile("s_waitcnt vmcnt(0)" ::: "memory");
        } else {
            XB_SPIN(xb_ld(&bar[XB_XGEN(b.x)]) == gen, bar);
            __builtin_amdgcn_fence(__ATOMIC_ACQUIRE, "agent");
            asm volatile("s_waitcnt vmcnt(0)" ::: "memory");
        }
    }
    __syncthreads();
}


#define GAS __attribute__((address_space(1)))
__device__ __forceinline__ void gemm_core(int tidx_, int bidx_, char* smem, const u16* __restrict__ Ag, long lda,
                                          const u16* __restrict__ Bg, long ldb, int K, f32x4 (&acc)[4][4], bool pre_issued) {
  const int tid = tidx_, lane = tid & 63, wid = tid >> 6, wr = wid >> 1, wc = wid & 1;
  const int lr = lane >> 3, lc = (lane & 7) ^ lr;
  const u16* ap = Ag + (long)(wid * 8 + lr) * lda + lc * 8;
  const u16* bp = Bg + (long)(wid * 8 + lr) * ldb + lc * 8;
  const int soff = wid * 1024 + lane * 16;
#define GLDS(buf, kofs) do { \
    _Pragma("unroll") for (int i_ = 0; i_ < 4; ++i_) { \
      __builtin_amdgcn_global_load_lds((const GAS void*)(ap + (long)(32 * i_) * lda + (kofs)), (LAS void*)((buf) + soff + i_ * 4096), 16, 0, 0); \
      __builtin_amdgcn_global_load_lds((const GAS void*)(bp + (long)(32 * i_) * ldb + (kofs)), (LAS void*)((buf) + 16384 + soff + i_ * 4096), 16, 0, 0); \
    } } while (0)
  if (!pre_issued) GLDS(smem, 0);
  asm volatile("s_waitcnt vmcnt(0)" ::: "memory");
  __syncthreads();
  const int nk = K >> 6;
  const int fr = lane & 15, fq = lane >> 4;
  const int aoff = (wr * 64 + fr) * 128;
  const int boff = 16384 + (wc * 64 + fr) * 128;
  for (int kt = 0; kt < nk; ++kt) {
    if (kt + 1 < nk) GLDS(smem + ((kt + 1) & 1) * 32768, (kt + 1) * 64);
    const char* sb = smem + (kt & 1) * 32768;
#pragma unroll
    for (int kk = 0; kk < 2; ++kk) {
      bf16x8 a[4], b[4];
      const int ch = ((kk * 4 + fq) ^ (fr & 7)) << 4;
#pragma unroll
      for (int m = 0; m < 4; ++m) a[m] = *(const bf16x8*)(sb + aoff + m * 2048 + ch);
#pragma unroll
      for (int n = 0; n < 4; ++n) b[n] = *(const bf16x8*)(sb + boff + n * 2048 + ch);
      __builtin_amdgcn_s_setprio(1);
#pragma unroll
      for (int m = 0; m < 4; ++m)
#pragma unroll
        for (int n = 0; n < 4; ++n) acc[m][n] = __builtin_amdgcn_mfma_f32_16x16x32_bf16(a[m], b[n], acc[m][n], 0, 0, 0);
      __builtin_amdgcn_s_setprio(0);
    }
    asm volatile("s_waitcnt vmcnt(0)" ::: "memory");
    __syncthreads();
  }
#undef GLDS
}

__device__ __forceinline__ void gemm_issue_first(int tidx_, char* smem, const u16* __restrict__ Ag, long lda,
                                                 const u16* __restrict__ Bg, long ldb) {
  const int lane = tidx_ & 63, wid = tidx_ >> 6;
  const int lr = lane >> 3, lc = (lane & 7) ^ lr;
  const u16* ap = Ag + (long)(wid * 8 + lr) * lda + lc * 8;
  const u16* bp = Bg + (long)(wid * 8 + lr) * ldb + lc * 8;
  const int soff = wid * 1024 + lane * 16;
#pragma unroll
  for (int i_ = 0; i_ < 4; ++i_) {
    __builtin_amdgcn_global_load_lds((const GAS void*)(ap + (long)(32 * i_) * lda), (LAS void*)(smem + soff + i_ * 4096), 16, 0, 0);
    __builtin_amdgcn_global_load_lds((const GAS void*)(bp + (long)(32 * i_) * ldb), (LAS void*)(smem + 16384 + soff + i_ * 4096), 16, 0, 0);
  }
}

__device__ __forceinline__ void gemm_core256(int tidx_, char* smem, const u16* __restrict__ Ag, long ars, long aks,
                                             const u16* __restrict__ Bg, long brs, long bks, int K, f32x4 (&acc)[4][8]) {
  const int lane = tidx_ & 63, wid = tidx_ >> 6, wr = wid >> 1, wc = wid & 1;
  const int rr = lane >> 2, cs = (lane & 3) ^ ((rr >> 2) & 3);
  const u16* ap = Ag + (long)(wid * 32 + rr) * ars + cs * 8;
  const u16* bp = Bg + (long)(wid * 64 + rr) * brs + cs * 8;
  const int sa = wid * 2048 + lane * 16, sbo = 8192 + wid * 4096 + lane * 16;
#define GLDS2(buf, kt_) do { \
    __builtin_amdgcn_global_load_lds((const GAS void*)(ap + (long)(kt_) * aks), (LAS void*)((buf) + sa), 16, 0, 0); \
    __builtin_amdgcn_global_load_lds((const GAS void*)(ap + 16 * ars + (long)(kt_) * aks), (LAS void*)((buf) + sa + 1024), 16, 0, 0); \
    _Pragma("unroll") for (int i_ = 0; i_ < 4; ++i_) \
      __builtin_amdgcn_global_load_lds((const GAS void*)(bp + (long)(16 * i_) * brs + (long)(kt_) * bks), (LAS void*)((buf) + sbo + i_ * 1024), 16, 0, 0); \
  } while (0)
  const int nk = K >> 5;
  GLDS2(smem, 0);
  if (nk > 1) GLDS2(smem + 24576, 1);
  const int fr = lane & 15, fq = lane >> 4;
  const int fsw = (fq ^ ((fr >> 2) & 3)) << 4;
  const int aoff = (wr * 64 + fr) * 64 + fsw;
  const int boff = 8192 + (wc * 128 + fr) * 64 + fsw;
  int slot = 0, slot2 = 2;
  for (int kt = 0; kt < nk; ++kt) {
    if (kt + 1 < nk) asm volatile("s_waitcnt vmcnt(6)" ::: "memory");
    else asm volatile("s_waitcnt vmcnt(0)" ::: "memory");
    asm volatile("s_waitcnt lgkmcnt(0)" ::: "memory");
    __builtin_amdgcn_s_barrier();
    asm volatile("" ::: "memory");
    if (kt + 2 < nk) GLDS2(smem + slot2 * 24576, kt + 2);
    const char* sb = smem + slot * 24576;
    bf16x8 a[4], b[8];
#pragma unroll
    for (int m = 0; m < 4; ++m) a[m] = *(const bf16x8*)(sb + aoff + m * 1024);
#pragma unroll
    for (int n = 0; n < 8; ++n) b[n] = *(const bf16x8*)(sb + boff + n * 1024);
    __builtin_amdgcn_s_setprio(1);
#pragma unroll
    for (int m = 0; m < 4; ++m)
#pragma unroll
      for (int n = 0; n < 8; ++n) acc[m][n] = __builtin_amdgcn_mfma_f32_16x16x32_bf16(a[m], b[n], acc[m][n], 0, 0, 0);
    __builtin_amdgcn_s_setprio(0);
    slot = (slot == 2) ? 0 : slot + 1;
    slot2 = (slot2 == 2) ? 0 : slot2 + 1;
  }
  asm volatile("s_waitcnt lgkmcnt(0)" ::: "memory");
  __builtin_amdgcn_s_barrier();
  asm volatile("" ::: "memory");
#undef GLDS2
}

enum { EPI_SWIGLU = 0, EPI_BF16 = 1, EPI_BF16_T = 2, EPI_F16 = 3 };

template <int NF>
__device__ __forceinline__ void gemm_epilogue(int tidx_, int bidx_, f32x4 (&acc)[4][NF], int epi, void* C, long ldc, int row0, int col0,
                                              float scale, int ncols) {
  const int lane = tidx_ & 63, wid = tidx_ >> 6, wr = wid >> 1, wc = wid & 1;
  const int fr = lane & 15, fq = lane >> 4;
  if (epi == EPI_SWIGLU) {
    u16* out = (u16*)C;
#pragma unroll
    for (int m = 0; m < 4; ++m)
#pragma unroll
      for (int pp = 0; pp < NF / 2; ++pp) {
        const int hc = ((col0 + wc * (NF * 16)) >> 1) + pp * 16 + fr;
#pragma unroll
        for (int j = 0; j < 4; ++j) {
          const int row = row0 + wr * 64 + m * 16 + fq * 4 + j;
          const float a = acc[m][2 * pp][j], u = acc[m][2 * pp + 1][j];
          const float s = a * __builtin_amdgcn_rcpf(1.f + __expf(-a));
          out[((long)(hc >> 5) * NT + row) * 32 + (hc & 31)] = f2bf(s * u);
        }
      }
  } else if (epi == EPI_BF16) {
    u16* out = (u16*)C;
#pragma unroll
    for (int m = 0; m < 4; ++m)
#pragma unroll
      for (int n = 0; n < NF; ++n) {
        const int col = col0 + wc * (NF * 16) + n * 16 + fr;
#pragma unroll
        for (int j = 0; j < 4; ++j) {
          const int row = row0 + wr * 64 + m * 16 + fq * 4 + j;
          out[(long)row * ldc + col] = f2bf(acc[m][n][j] * scale);
        }
      }
  } else if (epi == EPI_BF16_T) {
    u16* out = (u16*)C;
#pragma unroll
    for (int m = 0; m < 4; ++m)
#pragma unroll
      for (int n = 0; n < NF; ++n) {
        const int col = col0 + wc * (NF * 16) + n * 16 + fr;
        const int row = row0 + wr * 64 + m * 16 + fq * 4;
        uint2 v;
        v.x = pack2bf(acc[m][n][0], acc[m][n][1]);
        v.y = pack2bf(acc[m][n][2], acc[m][n][3]);
        *(uint2*)(out + (long)col * ldc + row) = v;
      }
  } else {
    _Float16* out = (_Float16*)C;
#pragma unroll
    for (int m = 0; m < 4; ++m)
#pragma unroll
      for (int n = 0; n < NF; ++n) {
        const int col = col0 + wc * (NF * 16) + n * 16 + fr;
        if (col < ncols) {
#pragma unroll
          for (int j = 0; j < 4; ++j) {
            const int row = row0 + wr * 64 + m * 16 + fq * 4 + j;
            out[(long)row * ldc + col] = (_Float16)acc[m][n][j];
          }
        }
      }
  }
}

struct GemmD {
  const u16 *A0, *A1, *B0, *B1;
  long lda, ldb, bsB, brs, bks, ars, aks;
  void* C;
  long ldc;
  int K, nseg, Mt, Ntl, nbatch, bsCrow, crow0, epi, ncols, wide;
  float scale;
};

__device__ __forceinline__ void gemm_tile_decode(const GemmD& d, int idx, int x, int Rx, int G, int wlast, int& b, int& mt, int& nt) {
  const int gsh = d.wide ? 2 : 3;
  int rl;
  if (idx < ((G * Rx) << gsh)) {
    const int ntg = idx / (Rx << gsh), rem = idx - ntg * (Rx << gsh);
    rl = rem >> gsh;
    nt = (ntg << gsh) + (rem & ((1 << gsh) - 1));
  } else {
    const int rem = idx - ((G * Rx) << gsh);
    rl = rem / wlast;
    nt = (G << gsh) + (rem - rl * wlast);
  }
  const int R = x * Rx + rl;
  b = R / d.Mt;
  mt = R - b * d.Mt;
}

__device__ __forceinline__ void gemm_job(int tidx_, int bidx_, char* smem, const GemmD& d) {
  const int x = bidx_ & 7, jloc = bidx_ >> 3, nloc = gridDim.x >> 3;
  const int Rx = (d.nbatch * d.Mt) >> 3;
  const int gsh = d.wide ? 2 : 3;
  const int G = d.Ntl >> gsh, wlast = d.Ntl - (G << gsh);
  const int total = Rx * d.Ntl;
  int b = 0, mt = 0, nt = 0;
  if (d.wide) {
    for (int idx = jloc; idx < total; idx += nloc) {
      gemm_tile_decode(d, idx, x, Rx, G, wlast, b, mt, nt);
      f32x4 acc[4][8];
#pragma unroll
      for (int m = 0; m < 4; ++m)
#pragma unroll
        for (int n = 0; n < 8; ++n) acc[m][n] = f32x4{0.f, 0.f, 0.f, 0.f};
      for (int s = 0; s < d.nseg; ++s)
        gemm_core256(tidx_, smem, (s ? d.A1 : d.A0) + (long)mt * 128 * (d.ars ? d.ars : d.lda), d.ars ? d.ars : d.lda, d.ars ? d.aks : 32,
                     (s ? d.B1 : d.B0) + (long)nt * 256 * (d.brs ? d.brs : d.ldb) + (long)b * d.bsB,
                     d.brs ? d.brs : d.ldb, d.brs ? d.bks : 32, d.K, acc);
      gemm_epilogue<8>(tidx_, bidx_, acc, d.epi, d.C, d.ldc, d.crow0 + b * d.bsCrow + mt * 128, nt * 256, d.scale, d.ncols);
    }
    return;
  }
  if (jloc < total) {
    gemm_tile_decode(d, jloc, x, Rx, G, wlast, b, mt, nt);
    gemm_issue_first(tidx_, smem, d.A0 + (long)mt * 128 * d.lda, d.lda, d.B0 + (long)nt * 128 * d.ldb + (long)b * d.bsB, d.ldb);
  }
  for (int idx = jloc; idx < total; idx += nloc) {
    f32x4 acc[4][4];
#pragma unroll
    for (int m = 0; m < 4; ++m)
#pragma unroll
      for (int n = 0; n < 4; ++n) acc[m][n] = f32x4{0.f, 0.f, 0.f, 0.f};
    for (int s = 0; s < d.nseg; ++s) {
      const u16* A = s ? d.A1 : d.A0;
      const u16* B = s ? d.B1 : d.B0;
      gemm_core(tidx_, bidx_, smem, A + (long)mt * 128 * d.lda, d.lda, B + (long)nt * 128 * d.ldb + (long)b * d.bsB, d.ldb, d.K, acc, s == 0);
    }
    const int crow = d.crow0 + b * d.bsCrow + mt * 128, ccol = nt * 128;
    if (idx + nloc < total) {
      gemm_tile_decode(d, idx + nloc, x, Rx, G, wlast, b, mt, nt);
      gemm_issue_first(tidx_, smem, d.A0 + (long)mt * 128 * d.lda, d.lda, d.B0 + (long)nt * 128 * d.ldb + (long)b * d.bsB, d.ldb);
    }
    gemm_epilogue<4>(tidx_, bidx_, acc, d.epi, d.C, d.ldc, crow, ccol, d.scale, d.ncols);
  }
}

__device__ __forceinline__ void convert_job(int tidx_, int bidx_, char* smem, const float* __restrict__ src, int pitch, int K, int nsrc, int Nout, u16* dst, int map, long brs, long bks) {
  float* t = (float*)smem;
  const int tilesN = Nout >> 6, tilesK = K >> 6;
  for (int tt = bidx_; tt < tilesN * tilesK; tt += gridDim.x) {
    const int n0 = (tt % tilesN) * 64, k0 = (tt / tilesN) * 64;
    for (int idx = tidx_; idx < 1024; idx += NTHR) {
      const int kk = idx >> 4, xx = (idx & 15) * 4;
      const int n = n0 + xx;
      int sc = n;
      if (map == 1) {
        const int q = n >> 5, w = n & 31;
        sc = (w < 16) ? (q * 16 + w) : (DFF + q * 16 + w - 16);
      }
      const float4 vv = *(const float4*)(src + (long)(k0 + kk) * pitch + min(sc, nsrc - 4));
      const bool ok = sc < nsrc;
      t[kk * 65 + xx] = ok ? vv.x : 0.f;
      t[kk * 65 + xx + 1] = ok ? vv.y : 0.f;
      t[kk * 65 + xx + 2] = ok ? vv.z : 0.f;
      t[kk * 65 + xx + 3] = ok ? vv.w : 0.f;
    }
    __syncthreads();
    for (int idx = tidx_; idx < 512; idx += NTHR) {
      const int xx = idx >> 3, cc = idx & 7;
      uint4 v;
      v.x = pack2bf(t[(cc * 8 + 0) * 65 + xx], t[(cc * 8 + 1) * 65 + xx]);
      v.y = pack2bf(t[(cc * 8 + 2) * 65 + xx], t[(cc * 8 + 3) * 65 + xx]);
      v.z = pack2bf(t[(cc * 8 + 4) * 65 + xx], t[(cc * 8 + 5) * 65 + xx]);
      v.w = pack2bf(t[(cc * 8 + 6) * 65 + xx], t[(cc * 8 + 7) * 65 + xx]);
      *(uint4*)(dst + (long)(n0 + xx) * brs + (long)((k0 + cc * 8) >> 5) * bks + ((k0 + cc * 8) & 31)) = v;
    }
    __syncthreads();
  }
}

__device__ __forceinline__ void mod_gemv(int tidx_, int bidx_, char* smem, const Params& p, float* modv) {
  float* s = (float*)smem;
  const int tid = tidx_, lane = tid & 63, wid = tid >> 6;
  for (int u = bidx_; u < 288; u += gridDim.x) {
    for (int idx = tid; idx < 17 * 1024; idx += NTHR) {
      const int r = idx >> 10, k = idx & 1023;
      const float v = (r < 16) ? p.c[r * 1024 + k] : p.c_ctx[k];
      s[idx] = v / (1.f + expf(-v));
    }
    __syncthreads();
    const int layer = u / 144, cb = (u % 144) * 64;
    const float* W = p.mod_w + (long)layer * 1024 * 9216 + cb + lane;
    float acc[17];
#pragma unroll
    for (int r = 0; r < 17; ++r) acc[r] = 0.f;
    const int kb = wid * 256;
#pragma unroll 1
    for (int k0 = kb; k0 < kb + 256; k0 += 16) {
      float w[16];
#pragma unroll
      for (int i = 0; i < 16; ++i) w[i] = W[(long)(k0 + i) * 9216];
#pragma unroll
      for (int i = 0; i < 16; ++i)
#pragma unroll
        for (int r = 0; r < 17; ++r) acc[r] += s[r * 1024 + k0 + i] * w[i];
    }
    __syncthreads();
#pragma unroll
    for (int r = 0; r < 17; ++r) s[(wid * 17 + r) * 64 + lane] = acc[r];
    __syncthreads();
    for (int idx = tid; idx < 17 * 64; idx += NTHR) {
      const int r = idx >> 6, cc = idx & 63;
      const float v = s[(0 * 17 + r) * 64 + cc] + s[(1 * 17 + r) * 64 + cc] + s[(2 * 17 + r) * 64 + cc] + s[(3 * 17 + r) * 64 + cc];
      modv[((long)layer * 17 + r) * 9216 + cb + cc] = v + p.mod_b[layer * 9216 + cb + cc];
    }
    __syncthreads();
  }
}

template <int NRW>
__device__ __forceinline__ void rowpass(int tidx_, int bidx_, const float* xs_lat, const float* xs_ctx, float* xd_lat, float* xd_ctx, bool do_post,
                        const u16* y, const float* modL, int gi, float gscale, const float* lng, const float* lnb,
                        const float* modN, int si, int ci, u16* h, int rbeg, int nrows) {
  const int lane = tidx_ & 63, wid = tidx_ >> 6;
  for (int rb = rbeg + (bidx_ * 4 + wid) * NRW; rb < nrows; rb += gridDim.x * 4 * NRW) {
    const int b = (rb < NLAT) ? (rb >> 11) : 16;
    const float* xs = (rb < NLAT) ? xs_lat + (long)rb * DM : xs_ctx + (long)(rb - NLAT) * DM;
    float* xd = (rb < NLAT) ? xd_lat + (long)rb * DM : xd_ctx + (long)(rb - NLAT) * DM;
    float v[NRW][16];
#pragma unroll
    for (int q = 0; q < NRW; ++q)
#pragma unroll
      for (int i = 0; i < 4; ++i) {
        typedef float f4v __attribute__((ext_vector_type(4)));
        const f4v t = __builtin_nontemporal_load((const f4v*)(xs + q * DM + i * 256 + lane * 4));
        v[q][4 * i] = t.x; v[q][4 * i + 1] = t.y; v[q][4 * i + 2] = t.z; v[q][4 * i + 3] = t.w;
      }
    if (do_post) {
      if (y) {
        const float* gate = modL + (long)b * 9216 + gi * 1024;
        uint2 yv[NRW][4];
#pragma unroll
        for (int q = 0; q < NRW; ++q)
#pragma unroll
          for (int i = 0; i < 4; ++i) {
            typedef unsigned u2v __attribute__((ext_vector_type(2)));
            const u2v yy = __builtin_nontemporal_load((const u2v*)(y + (long)(rb + q) * DM + i * 256 + lane * 4));
            yv[q][i].x = yy.x; yv[q][i].y = yy.y;
          }
#pragma unroll
        for (int i = 0; i < 4; ++i) {
          const float4 g = *(const float4*)(gate + i * 256 + lane * 4);
#pragma unroll
          for (int q = 0; q < NRW; ++q) {
            v[q][4 * i] = ALPHA_F * v[q][4 * i] + gscale * g.x * bf2f((u16)(yv[q][i].x & 0xffff));
            v[q][4 * i + 1] = ALPHA_F * v[q][4 * i + 1] + gscale * g.y * bf2f((u16)(yv[q][i].x >> 16));
            v[q][4 * i + 2] = ALPHA_F * v[q][4 * i + 2] + gscale * g.z * bf2f((u16)(yv[q][i].y & 0xffff));
            v[q][4 * i + 3] = ALPHA_F * v[q][4 * i + 3] + gscale * g.w * bf2f((u16)(yv[q][i].y >> 16));
          }
        }
      } else {
#pragma unroll
        for (int q = 0; q < NRW; ++q)
#pragma unroll
          for (int i = 0; i < 16; ++i) v[q][i] *= ALPHA_F;
      }
      float mean[NRW], rstd[NRW];
#pragma unroll
      for (int q = 0; q < NRW; ++q) {
        float sum = 0.f;
#pragma unroll
        for (int i = 0; i < 16; ++i) sum += v[q][i];
        mean[q] = wave_sum(sum) * (1.f / DM);
        float sq = 0.f;
#pragma unroll
        for (int i = 0; i < 16; ++i) { const float d = v[q][i] - mean[q]; sq += d * d; }
        rstd[q] = rsqrtf(wave_sum(sq) * (1.f / DM) + LN_EPS);
      }
#pragma unroll
      for (int i = 0; i < 4; ++i) {
        const int col = i * 256 + lane * 4;
        const float4 g = *(const float4*)(lng + col);
        const float4 bb = *(const float4*)(lnb + col);
#pragma unroll
        for (int q = 0; q < NRW; ++q) {
          v[q][4 * i] = (v[q][4 * i] - mean[q]) * rstd[q] * g.x + bb.x;
          v[q][4 * i + 1] = (v[q][4 * i + 1] - mean[q]) * rstd[q] * g.y + bb.y;
          v[q][4 * i + 2] = (v[q][4 * i + 2] - mean[q]) * rstd[q] * g.z + bb.z;
          v[q][4 * i + 3] = (v[q][4 * i + 3] - mean[q]) * rstd[q] * g.w + bb.w;
          {
            typedef float f4s __attribute__((ext_vector_type(4)));
            const f4s xo = {v[q][4 * i], v[q][4 * i + 1], v[q][4 * i + 2], v[q][4 * i + 3]};
            __builtin_nontemporal_store(xo, (f4s*)(xd + q * DM + col));
          }
        }
      }
    }
    if (h) {
      float mean[NRW], rstd[NRW];
#pragma unroll
      for (int q = 0; q < NRW; ++q) {
        float sum = 0.f;
#pragma unroll
        for (int i = 0; i < 16; ++i) sum += v[q][i];
        mean[q] = wave_sum(sum) * (1.f / DM);
        float sq = 0.f;
#pragma unroll
        for (int i = 0; i < 16; ++i) { const float d = v[q][i] - mean[q]; sq += d * d; }
        rstd[q] = rsqrtf(wave_sum(sq) * (1.f / DM) + LN_EPS);
      }
      const float* sh = modN + (long)b * 9216 + si * 1024;
      const float* sc = modN + (long)b * 9216 + ci * 1024;
#pragma unroll
      for (int i = 0; i < 4; ++i) {
        const int col = i * 256 + lane * 4;
        const float4 s4 = *(const float4*)(sh + col);
        const float4 c4 = *(const float4*)(sc + col);
#pragma unroll
        for (int q = 0; q < NRW; ++q) {
          uint2 o;
          o.x = pack2bf((v[q][4 * i] - mean[q]) * rstd[q] * (1.f + c4.x) + s4.x, (v[q][4 * i + 1] - mean[q]) * rstd[q] * (1.f + c4.y) + s4.y);
          o.y = pack2bf((v[q][4 * i + 2] - mean[q]) * rstd[q] * (1.f + c4.z) + s4.z, (v[q][4 * i + 3] - mean[q]) * rstd[q] * (1.f + c4.w) + s4.w);
          *(uint2*)(h + ((long)(col >> 5) * NT + (rb + q)) * 32 + (col & 31)) = o;
        }
      }
    }
  }
}
__device__ __forceinline__ void fusew_job(int tidx_, int bidx_, char* smem, const float* __restrict__ w  , u16* dst) {
  float* t = (float*)smem;
  float* ct = t + 64 * 65;
  float* st = ct + 64;
  for (int u = bidx_; u < 128; u += gridDim.x) {
    const int g = u & 7, k0 = (u >> 3) * 64;
    for (int idx = tidx_; idx < 4096; idx += NTHR) {
      const int kk = idx >> 6, cc = idx & 63;
      t[kk * 65 + cc] = w[(long)(k0 + kk) * 2048 + g * 64 + cc];
    }
    if (tidx_ < 64) {
      float s, c;
      sincosf(6.283185307179586f * tidx_ / 64.f, &s, &c);
      ct[tidx_] = c;
      st[tidx_] = s;
    }
    __syncthreads();
    for (int idx = tidx_; idx < 1024; idx += NTHR) {
      const int which = idx >> 9, rem = idx & 511, cp = rem >> 3, cc = rem & 7;
      const float* tab = which ? st : ct;
      float o[8];
#pragma unroll
      for (int j = 0; j < 8; ++j) {
        const float* row = t + (cc * 8 + j) * 65;
        float a = 0.f;
        for (int c = 0; c < 64; ++c) a += row[c] * tab[(c * cp) & 63];
        o[j] = a;
      }
      uint4 v;
      v.x = pack2bf(o[0], o[1]); v.y = pack2bf(o[2], o[3]); v.z = pack2bf(o[4], o[5]); v.w = pack2bf(o[6], o[7]);
      *(uint4*)(dst + (long)(which * 512 + g * 64 + cp) * 32 + (long)((k0 + cc * 8) >> 5) * (2560 * 32) + ((k0 + cc * 8) & 31)) = v;
    }
    __syncthreads();
  }
}

__device__ __forceinline__ void dft_job(int tidx_, int bidx_, u16* DC, u16* DS) {
  for (int idx = bidx_ * NTHR + tidx_; idx < 2048 * 256; idx += gridDim.x * NTHR) {
    const int lp = idx >> 8, l0 = (idx & 255) * 8;
    float c[8], s[8];
#pragma unroll
    for (int j = 0; j < 8; ++j) {
      const int m = (lp * (l0 + j)) & 2047;
      sincosf((float)m * (6.283185307179586f / 2048.f), &s[j], &c[j]);
    }
    uint4 vc, vs;
    vc.x = pack2bf(c[0], c[1]); vc.y = pack2bf(c[2], c[3]); vc.z = pack2bf(c[4], c[5]); vc.w = pack2bf(c[6], c[7]);
    vs.x = pack2bf(-s[0], -s[1]); vs.y = pack2bf(-s[2], -s[3]); vs.z = pack2bf(-s[4], -s[5]); vs.w = pack2bf(-s[6], -s[7]);
    *(uint4*)(DC + (long)lp * 2048 + l0) = vc;
    *(uint4*)(DS + (long)lp * 2048 + l0) = vs;
  }
}

__device__ __forceinline__ void hd2_job(int tidx_, int bidx_, char* smem, const Params& p, float* HD2) {
  float* z = (float*)smem;
  float* h1 = z + 4 * 36;
  const int tid = tidx_;
  for (int u = bidx_; u < 576; u += gridDim.x) {
    if (tid < 132) {
      const int pp = tid / 33, i = tid % 33;
      const int P = u * 4 + pp;
      const int L = (P < 2048) ? 2048 : 256;
      const int pos = (P < 2048) ? P : P - 2048;
      float val;
      if (i == 0) val = (float)pos / (float)(L - 1);
      else {
        const int band = (i - 1) & 15;
        const float fr = 1e-4f + (float)band * ((15.f - 1e-4f) / 15.f);
        const float w = 6.283185307179586f * (float)pos * fr / (float)L;
        val = (i >= 17) ? -sinf(w) : cosf(w);
      }
      z[pp * 36 + i] = val;
    }
    __syncthreads();
    const int pp = tid >> 6, o = tid & 63;
    const float fq = p.hy_freq[o];
    float a = p.hy_b1[o];
    for (int i = 0; i < 33; ++i) a += z[pp * 36 + i] * p.hy_w1[i * 64 + o];
    h1[pp * 64 + o] = sinf(fq * a);
    __syncthreads();
    float a2 = p.hy_b2[o];
    for (int i = 0; i < 64; ++i) a2 += h1[pp * 64 + i] * p.hy_w2[i * 64 + o];
    HD2[(long)(u * 4 + pp) * 64 + o] = sinf(fq * a2);
    __syncthreads();
  }
}

__device__ __forceinline__ void fraw_job(int tidx_, int bidx_, char* smem, const Params& p, const float* HD2, float* FR) {
  float* w3s = (float*)smem;
  const int tid = tidx_;
  for (int u = bidx_; u < 288; u += gridDim.x) {
    const int lt = (u >= 256) ? 1 : 0;
    const int uu = lt ? u - 256 : u;
    const int L = lt ? 256 : 2048;
    const int pb = lt ? 0 : (uu >> 5), jb = uu & 31;
    const int pos = pb * 256 + tid;
    const long P = (lt ? 2048 : 0) + pos;
    float hd[64];
#pragma unroll
    for (int i = 0; i < 16; ++i) {
      const float4 v = *(const float4*)(HD2 + P * 64 + i * 4);
      hd[4 * i] = v.x; hd[4 * i + 1] = v.y; hd[4 * i + 2] = v.z; hd[4 * i + 3] = v.w;
    }
    for (int idx = tid; idx < 4096; idx += NTHR) w3s[idx] = p.hy_w3[(long)(idx >> 6) * 2048 + jb * 64 + (idx & 63)];
    __syncthreads();
    const float t = (float)pos / (float)(L - 1);
    float* out = FR + (lt ? (long)2048 * 2048 : 0);
    const float da = -3.0701134573253945f, db = -15.350567286626973f;
    for (int jj = 0; jj < 64; ++jj) {
      float a = 0.f;
#pragma unroll
      for (int i = 0; i < 64; ++i) a += hd[i] * w3s[i * 64 + jj];
      const int j = jb * 64 + jj, ch = j & 511;
      const float delta = fabsf(da + (db - da) * (float)ch / 511.f);
      out[(long)j * L + pos] = a * expf(-t * delta);
    }
    __syncthreads();
  }
}

__device__ __forceinline__ void sconv_job(int tidx_, int bidx_, const Params& p, const u16* __restrict__ U, u16* __restrict__ V) {
  const int per = NT / 8;
  for (long idx = (long)bidx_ * NTHR + tidx_; idx < (long)1536 * per; idx += (long)gridDim.x * NTHR) {
    const int j = (int)(idx / per), tok0 = (int)(idx % per) * 8;
    int ls, L;
    if (tok0 < NLAT) { ls = tok0 & 2047; L = 2048; } else { ls = (tok0 - NLAT) & 255; L = 256; }
    const u16* row = U + (long)j * NT;
    const uint4 cur = *(const uint4*)(row + tok0);
    float x[10];
    const u16 xl = row[max(tok0 - 1, 0)], xr = row[min(tok0 + 8, NT - 1)];
    x[0] = (ls > 0) ? bf2f(xl) : 0.f;
    x[9] = (ls + 8 < L) ? bf2f(xr) : 0.f;
    x[1] = bf2f((u16)(cur.x & 0xffff)); x[2] = bf2f((u16)(cur.x >> 16));
    x[3] = bf2f((u16)(cur.y & 0xffff)); x[4] = bf2f((u16)(cur.y >> 16));
    x[5] = bf2f((u16)(cur.z & 0xffff)); x[6] = bf2f((u16)(cur.z >> 16));
    x[7] = bf2f((u16)(cur.w & 0xffff)); x[8] = bf2f((u16)(cur.w >> 16));
    const float w0 = p.hy_conv_w[j], w1 = p.hy_conv_w[1536 + j], w2 = p.hy_conv_w[3072 + j], bb = p.hy_conv_b[j];
    float o[8];
#pragma unroll
    for (int i = 0; i < 8; ++i) o[i] = w0 * x[i] + w1 * x[i + 1] + w2 * x[i + 2] + bb;
    uint4 v;
    v.x = pack2bf(o[0], o[1]); v.y = pack2bf(o[2], o[3]); v.z = pack2bf(o[4], o[5]); v.w = pack2bf(o[6], o[7]);
    *(uint4*)(V + (long)j * NT + tok0) = v;
  }
}

template <int TT>
__device__ __forceinline__ void toep_unit(int tidx_, int bidx_, char* smem, const Params& p, int ch, int tokbase, const float* FRl, const u16* V, u16* z1row, u16* z2row) {
  constexpr int L = 128 * TT;
  constexpr int ES = (TT == 16) ? 4112 : 528;
  u16* E = (u16*)smem;
  float* red = (float*)(smem + 8 * ES * 2);
  const int tid = tidx_, lane = tid & 63, wid = tid >> 6;
  const int fr = lane & 15, fq = lane >> 4;
  const u16* vrow = V + (long)ch * NT;
  for (int o = 0; o < 2; ++o) {
    const u16* zsrc = o ? z1row : vrow;
    u16* zdst = o ? z2row : z1row;
    const float* fwd = FRl + (long)(o * 512 + ch) * L;
    const float* bwd = FRl + (long)(1024 + o * 512 + ch) * L;
    float s = 0.f;
    for (int i = tid; i < L; i += NTHR) {
      const float fb = fabsf(bwd[i]);
      s += fabsf(fwd[i]) + ((i > 0) ? fb : 0.f);
    }
    s = wave_sum(s);
    if (lane == 0) red[wid] = s;
    __syncthreads();
    const float scale = 1.f / (red[0] + red[1] + red[2] + red[3] + 1e-6f);
    for (int idx = tid; idx < 8 * ES; idx += NTHR) {
      const int rho = idx / ES, m = idx - rho * ES;
      const int dp = m - rho - L;
      const float vf = fwd[min(max(-dp, 0), L - 1)];
      const float vb = bwd[min(max(dp, 0), L - 1)];
      float v = (dp <= 0) ? vf : vb;
      if (dp <= -L || dp >= L) v = 0.f;
      E[idx] = f2bf(v * scale);
    }
    __syncthreads();
    const float skip = p.hy_skip[o * 512 + ch];
    const u16* xg = V + (long)(512 + o * 512 + ch) * NT;
    const u16* bsrc = zsrc + tokbase + fr * L + fq * 8;
#pragma unroll 1
    for (int s2 = 0; s2 < 2; ++s2) {
      f32x4 acc[TT];
#pragma unroll
      for (int t = 0; t < TT; ++t) acc[t] = f32x4{0.f, 0.f, 0.f, 0.f};
      const u16* e0 = E + (fr & 7) * ES + 8 * fq - 32 * wid - 16 * s2 - 8 * (fr >> 3) + L;
      bf16x8 cur[4], nxt[4];
#pragma unroll
      for (int i = 0; i < 4; ++i) { cur[i] = *(const bf16x8*)(bsrc + i * 32); nxt[i] = cur[i]; }
#pragma unroll 1
      for (int kb0 = 0; kb0 < L / 32; kb0 += 4) {
        if (kb0 + 4 < L / 32) {
#pragma unroll
          for (int i = 0; i < 4; ++i) nxt[i] = *(const bf16x8*)(bsrc + (kb0 + 4 + i) * 32);
        }
#pragma unroll
        for (int i = 0; i < 4; ++i) {
          bf16x8 af[TT];
#pragma unroll
          for (int t = 0; t < TT; ++t) af[t] = *(const bf16x8*)(e0 + 32 * (kb0 + i) - 128 * t);
          __builtin_amdgcn_sched_barrier(0);
#pragma unroll
          for (int t = 0; t < TT; ++t) acc[t] = __builtin_amdgcn_mfma_f32_16x16x32_bf16(af[t], cur[i], acc[t], 0, 0, 0);
          __builtin_amdgcn_sched_barrier(0);
        }
#pragma unroll
        for (int i = 0; i < 4; ++i) cur[i] = nxt[i];
      }
      uint2 zz[TT], xx[TT];
#pragma unroll
      for (int t = 0; t < TT; ++t) {
        const int tok = tokbase + fr * L + 128 * t + 32 * wid + 16 * s2 + fq * 4;
        zz[t] = *(const uint2*)(zsrc + tok);
        xx[t] = *(const uint2*)(xg + tok);
      }
#pragma unroll
      for (int t = 0; t < TT; ++t) {
        const int tok = tokbase + fr * L + 128 * t + 32 * wid + 16 * s2 + fq * 4;
        uint2 rr;
        rr.x = pack2bf(bf2f((u16)(xx[t].x & 0xffff)) * (acc[t][0] + bf2f((u16)(zz[t].x & 0xffff)) * skip),
                       bf2f((u16)(xx[t].x >> 16)) * (acc[t][1] + bf2f((u16)(zz[t].x >> 16)) * skip));
        rr.y = pack2bf(bf2f((u16)(xx[t].y & 0xffff)) * (acc[t][2] + bf2f((u16)(zz[t].y & 0xffff)) * skip),
                       bf2f((u16)(xx[t].y >> 16)) * (acc[t][3] + bf2f((u16)(zz[t].y >> 16)) * skip));
        *(uint2*)(zdst + tok) = rr;
      }
    }
    __syncthreads();
  }
}

__device__ __forceinline__ void ztrans_job(int tidx_, int bidx_, char* smem, const u16* __restrict__ Z2, u16* ymix) {
  u16* tl = (u16*)smem;
  const int ntt = NT / 64;
  for (int u = bidx_; u < 8 * ntt; u += gridDim.x) {
    const int cb = (u & 7) * 64, t0 = (u >> 3) * 64;
    for (int idx = tidx_; idx < 512; idx += NTHR) {
      const int c = idx >> 3, k = idx & 7;
      *(bf16x8*)(tl + c * 72 + k * 8) = *(const bf16x8*)(Z2 + (long)(cb + c) * NT + t0 + k * 8);
    }
    __syncthreads();
    for (int idx = tidx_; idx < 512; idx += NTHR) {
      const int tk = idx >> 3, k = idx & 7;
      bf16x8 v;
#pragma unroll
      for (int e = 0; e < 8; ++e) v[e] = (short)tl[(k * 8 + e) * 72 + tk];
      *(bf16x8*)(ymix + (long)(t0 + tk) * DM + 512 + cb + k * 8) = v;
    }
    __syncthreads();
  }
}

__device__ __forceinline__ void toep_job(int tidx_, int bidx_, char* smem, const Params& p, const float* FR, const u16* V, u16* Z1, u16* Z2) {
  for (int u = bidx_; u < 1024; u += gridDim.x) {
    if (u < 512) toep_unit<16>(tidx_, bidx_, smem, p, u, 0, FR, V, Z1 + (long)u * NT, Z2 + (long)u * NT);
    else toep_unit<2>(tidx_, bidx_, smem, p, u - 512, NLAT, FR + (long)2048 * 2048, V, Z1 + (long)(u - 512) * NT, Z2 + (long)(u - 512) * NT);
  }
}


__device__ __forceinline__ void lds_barrier() {
  asm volatile("s_waitcnt lgkmcnt(0)" ::: "memory");
  __builtin_amdgcn_s_barrier();
  asm volatile("" ::: "memory");
}

__device__ __forceinline__ int scan_row(bool hg, int step, int dir, int b, int j) {
  if (step < 4) {
    const int pc = step * 64 + j;
    return NLAT + b * 256 + (dir ? 255 - pc : pc);
  }
  const int pl = (step - 4) * 64 + j;
  const int sp = dir ? 2047 - pl : pl;
  const int l = hg ? ((sp & 31) * 64 + (sp >> 5)) : sp;
  return b * 2048 + l;
}

using f16x8 = __attribute__((ext_vector_type(8))) _Float16;

template <int DK, bool HG>
__device__ __forceinline__ void scan_unit(int tidx_, char* smem, const Params& p, const _Float16* __restrict__ PROJ, u16* Of, u16* Ob,
                                          const float* LB, int b, int head, int vs) {
  constexpr int PQ = DK + 8, PJ = 72, P = 256 / DK, TP = 64 / P, NDF = DK / 64, CPR = DK / 8;
  u16* QIN = (u16*)smem;
  u16* KIN = QIN + 64 * PQ;
  u16* KINT = KIN + 64 * PQ;
  u16* VT = KINT + DK * PJ;
  u16* ATT = VT + 32 * PJ;
  u16* ST = ATT + 64 * PJ;
  float* EGL = (float*)(ST + 32 * PQ);
  float* PS = EGL + DK;
  float* XG = PS + P * DK;
  _Float16* GRAW = (_Float16*)ATT;
  float* AF = (float*)ATT;
  _Float16* QH = (_Float16*)QIN;
  _Float16* KH = (_Float16*)KIN;
  const int lane = tidx_ & 63, wid = tidx_ >> 6, fr = lane & 15, fq = lane >> 4;
  const int cd = tidx_ % DK;
  const int qcol = HG ? 1568 + head * 128 : head * 64;
  const int kcol = 256 + head * 64;
  const int vcol = (HG ? 3104 : 512) + head * 128 + vs * 32;
  const int ocol = (HG ? 512 : 0) + head * 128 + vs * 32;
  const float lbv = HG ? LB[head * 128 + cd] : 0.f;
  for (int dir = 1; dir >= 0; --dir) {
    __syncthreads();
    const int gcol = HG ? (dir ? 2592 : 2080) + head * 128 : (dir ? 1552 : 1536);
    float aup[16];
    float abias = 0.f;
#pragma unroll
    for (int r = 0; r < 16; ++r) aup[r] = HG ? 0.f : p.gla_a_up[(dir * 16 + r) * 256 + head * 64 + (cd & 63)];
    if (!HG) abias = p.gla_a_b[dir * 256 + head * 64 + (cd & 63)];
    f32x4 S[NDF][2];
#pragma unroll
    for (int df = 0; df < NDF; ++df) { S[df][0] = f32x4{0.f, 0.f, 0.f, 0.f}; S[df][1] = f32x4{0.f, 0.f, 0.f, 0.f}; }
    constexpr int NIT = DK / 32;
    f16x8 rq[NIT], rk[NIT], rv, raf;
#define SCAN_LOAD(stp) do { \
      _Pragma("unroll") for (int it = 0; it < NIT; ++it) { \
        const int idx_ = tidx_ + it * NTHR; const int j_ = idx_ / CPR, c_ = idx_ % CPR; \
        const _Float16* rp_ = PROJ + (long)scan_row(HG, (stp), dir, b, j_) * 4128; \
        rq[it] = *(const f16x8*)(rp_ + qcol + c_ * 8); \
        rk[it] = *(const f16x8*)(rp_ + (HG ? gcol : kcol) + c_ * 8); \
      } \
      if (!HG) raf = *(const f16x8*)(PROJ + (long)scan_row(HG, (stp), dir, b, (tidx_ >> 1) & 63) * 4128 + gcol + (tidx_ & 1) * 8); \
      rv = *(const f16x8*)(PROJ + (long)scan_row(HG, (stp), dir, b, tidx_ >> 2) * 4128 + vcol + (tidx_ & 3) * 8); \
    } while (0)
    SCAN_LOAD(0);
#pragma unroll 1
    for (int step = 0; step < 36; ++step) {
      const bool isctx = step < 4;
#pragma unroll
      for (int it = 0; it < NIT; ++it) {
        const int idx = tidx_ + it * NTHR;
        const int j = idx / CPR, c = idx % CPR;
        *(f16x8*)(QH + j * PQ + c * 8) = rq[it];
        if (!HG) *(f16x8*)(KH + j * PQ + c * 8) = rk[it];
        else *(f16x8*)(GRAW + j * DK + c * 8) = rk[it];
      }
      if (!HG && tidx_ < 128) {
        const int j = tidx_ >> 1, c = tidx_ & 1;
#pragma unroll
        for (int e = 0; e < 8; ++e) AF[j * 16 + c * 8 + e] = (float)raf[e];
      }
      {
        const int j = tidx_ >> 2, c = tidx_ & 3;
#pragma unroll
        for (int e = 0; e < 8; ++e) VT[(c * 8 + e) * PJ + j] = f2bf((float)rv[e]);
      }
      if (step + 1 < 36) SCAN_LOAD(step + 1);
      lds_barrier();
      if (!HG) {
        const int c2 = tidx_ & 63, jq = tidx_ >> 6;
#pragma unroll 4
        for (int jj = 0; jj < 16; ++jj) {
          const int j = jq * 16 + jj;
          float x = abias;
#pragma unroll
          for (int r4 = 0; r4 < 4; ++r4) {
            const float4 a4 = *(const float4*)(AF + j * 16 + r4 * 4);
            x += a4.x * aup[4 * r4] + a4.y * aup[4 * r4 + 1] + a4.z * aup[4 * r4 + 2] + a4.w * aup[4 * r4 + 3];
          }
          const float g = (fminf(x, 0.f) - __logf(1.f + __expf(-fabsf(x)))) * (1.f / 16.f);
          XG[j * DK + c2] = __expf(g);
        }
        lds_barrier();
      }
      const int tb = HG ? tidx_ : tidx_ - ((vs & 1) ? 128 : 0);
      const int part = tb / DK;
      if (HG || (tb >= 0 && tb < 128)) {
        float pr = 1.f;
#pragma unroll 8
        for (int jj = 0; jj < 32; ++jj) {
          const int j = part ? 32 + jj : 31 - jj;
          const float qv = (float)QH[j * PQ + cd];
          float gf, kv;
          if (HG) {
            const float x = (float)GRAW[j * DK + cd];
            gf = lbv + (1.f - lbv) * __builtin_amdgcn_rcpf(1.f + __expf(-x));
            kv = 1.f - gf;
          } else {
            gf = XG[j * DK + cd];
            kv = (float)KH[j * PQ + cd];
          }
          const float nx = pr * gf;
          const float use = part ? nx : pr;
          const float oth = __builtin_amdgcn_rcpf(use);
          const float eg = part ? use : oth;
          const float eng = part ? oth : use;
          pr = nx;
          unsigned pk;
          asm("v_cvt_pk_bf16_f32 %0, %1, %2" : "=v"(pk) : "v"(qv * eg * (HG ? 1.f : 0.125f)), "v"(kv * eng));
          const u16 kb = (u16)(pk >> 16);
          QIN[j * PQ + cd] = (u16)(pk & 0xffffu);
          KIN[j * PQ + cd] = kb;
          KINT[cd * PJ + j] = kb;
        }
        if (part) EGL[cd] = pr;
        else PS[cd] = pr;
      }
      lds_barrier();
      if (!isctx) {
        f32x4 at[4];
#pragma unroll
        for (int jf = 0; jf < 4; ++jf) at[jf] = f32x4{0.f, 0.f, 0.f, 0.f};
#pragma unroll
        for (int ks = 0; ks < DK / 32; ++ks) {
          const bf16x8 a = *(const bf16x8*)(QIN + (wid * 16 + fr) * PQ + ks * 32 + fq * 8);
#pragma unroll
          for (int jf = 0; jf < 4; ++jf)
            if (jf <= wid) {
              const bf16x8 bb = *(const bf16x8*)(KIN + (jf * 16 + fr) * PQ + ks * 32 + fq * 8);
              at[jf] = __builtin_amdgcn_mfma_f32_16x16x32_bf16(a, bb, at[jf], 0, 0, 0);
            }
        }
#pragma unroll
        for (int jf = 0; jf < 4; ++jf)
#pragma unroll
          for (int rg = 0; rg < 4; ++rg) {
            const int i = wid * 16 + fq * 4 + rg, j = jf * 16 + fr;
            ATT[i * PJ + j] = f2bf((j <= i) ? at[jf][rg] : 0.f);
          }
#pragma unroll
        for (int df = 0; df < NDF; ++df)
#pragma unroll
          for (int vf = 0; vf < 2; ++vf) {
            const float* ec = PS + (wid + 4 * df) * 16 + fq * 4;
            uint2 pk;
            pk.x = pack2bf(ec[0] * S[df][vf][0], ec[1] * S[df][vf][1]);
            pk.y = pack2bf(ec[2] * S[df][vf][2], ec[3] * S[df][vf][3]);
            *(uint2*)(ST + (vf * 16 + fr) * PQ + (wid + 4 * df) * 16 + fq * 4) = pk;
          }
      }
      lds_barrier();
      if (!isctx) {
        f32x4 oa[2];
        oa[0] = f32x4{0.f, 0.f, 0.f, 0.f};
        oa[1] = f32x4{0.f, 0.f, 0.f, 0.f};
#pragma unroll
        for (int ks = 0; ks < 2; ++ks) {
          const bf16x8 a = *(const bf16x8*)(ATT + (wid * 16 + fr) * PJ + ks * 32 + fq * 8);
#pragma unroll
          for (int vf = 0; vf < 2; ++vf) {
            const bf16x8 bb = *(const bf16x8*)(VT + (vf * 16 + fr) * PJ + ks * 32 + fq * 8);
            oa[vf] = __builtin_amdgcn_mfma_f32_16x16x32_bf16(a, bb, oa[vf], 0, 0, 0);
          }
        }
#pragma unroll
        for (int ks = 0; ks < DK / 32; ++ks) {
          const bf16x8 a = *(const bf16x8*)(QIN + (wid * 16 + fr) * PQ + ks * 32 + fq * 8);
#pragma unroll
          for (int vf = 0; vf < 2; ++vf) {
            const bf16x8 bb = *(const bf16x8*)(ST + (vf * 16 + fr) * PQ + ks * 32 + fq * 8);
            oa[vf] = __builtin_amdgcn_mfma_f32_16x16x32_bf16(a, bb, oa[vf], 0, 0, 0);
          }
        }
#pragma unroll
        for (int rg = 0; rg < 4; ++rg) {
          const long row = scan_row(HG, step, dir, b, wid * 16 + fq * 4 + rg);
#pragma unroll
          for (int vf = 0; vf < 2; ++vf) {
            (dir ? Ob : Of)[row * DM + ocol + vf * 16 + fr] = f2bf(oa[vf][rg]);
          }
        }
      }
#pragma unroll
      for (int df = 0; df < NDF; ++df)
#pragma unroll
        for (int vf = 0; vf < 2; ++vf) {
          f32x4 u = f32x4{0.f, 0.f, 0.f, 0.f};
#pragma unroll
          for (int ks = 0; ks < 2; ++ks) {
            const bf16x8 a = *(const bf16x8*)(KINT + ((wid + 4 * df) * 16 + fr) * PJ + ks * 32 + fq * 8);
            const bf16x8 bb = *(const bf16x8*)(VT + (vf * 16 + fr) * PJ + ks * 32 + fq * 8);
            u = __builtin_amdgcn_mfma_f32_16x16x32_bf16(a, bb, u, 0, 0, 0);
          }
#pragma unroll
          for (int rg = 0; rg < 4; ++rg) {
            const int dd = (wid + 4 * df) * 16 + fq * 4 + rg;
            S[df][vf][rg] = EGL[dd] * (PS[dd] * S[df][vf][rg] + u[rg]);
          }
        }
      lds_barrier();
    }
  }
}

#undef SCAN_LOAD
__device__ __forceinline__ void scan_job(int tidx_, int bidx_, char* smem, const Params& p, const _Float16* PROJ, u16* Of, u16* Ob, const float* LB) {
  for (int u = bidx_; u < 512; u += gridDim.x) {
    const int hg = u & 1, r = u >> 1;
    const int b = r >> 4, head = (r >> 2) & 3, vs = r & 3;
    if (hg) scan_unit<128, true>(tidx_, smem, p, PROJ, Of, Ob, LB, b, head, vs);
    else scan_unit<64, false>(tidx_, smem, p, PROJ, Of, Ob, LB, b, head, vs);
  }
}

__device__ __forceinline__ void readout_job(int tidx_, int bidx_, const Params& p, const _Float16* __restrict__ PROJ, const u16* __restrict__ O, u16* ymix) {
  const int lane = tidx_ & 63, wid = tidx_ >> 6;
  const int grp = lane >> 3, c0 = (lane & 7) * 16;
  const bool ishg = grp >= 4;
  const float* gw = ishg ? p.hg_norm_g : p.gla_norm_g;
  for (int r = bidx_ * 4 + wid; r < NLAT; r += gridDim.x * 4) {
    const int col = grp * 128 + c0;
    const int gatecol = ishg ? 3616 + (grp - 4) * 128 + c0 : 1024 + grp * 128 + c0;
    float v[16], mul[16];
    float ss = 0.f;
#pragma unroll
    for (int h2 = 0; h2 < 2; ++h2) {
      const bf16x8 ov = *(const bf16x8*)(O + (long)r * DM + col + h2 * 8);
      const bf16x8 ow = *(const bf16x8*)(ymix + (long)r * DM + col + h2 * 8);
      const f16x8 gv = *(const f16x8*)(PROJ + (long)r * 4128 + gatecol + h2 * 8);
#pragma unroll
      for (int e = 0; e < 8; ++e) {
        const float o = bf2f((u16)ov[e]) + bf2f((u16)ow[e]);
        const float g = (float)gv[e];
        const float sg = __builtin_amdgcn_rcpf(1.f + __expf(-g));
        const float t = ishg ? o * sg : o;
        v[h2 * 8 + e] = t;
        mul[h2 * 8 + e] = ishg ? 1.f : g * sg;
        ss += t * t;
      }
    }
    ss += __shfl_xor(ss, 1);
    ss += __shfl_xor(ss, 2);
    ss += __shfl_xor(ss, 4);
    const float rinv = rsqrtf(ss * (1.f / 128.f) + LN_EPS);
    unsigned pk[8];
#pragma unroll
    for (int e = 0; e < 8; ++e)
      pk[e] = pack2bf(v[2 * e] * rinv * gw[c0 + 2 * e] * mul[2 * e], v[2 * e + 1] * rinv * gw[c0 + 2 * e + 1] * mul[2 * e + 1]);
    *(uint4*)(ymix + (long)r * DM + col) = uint4{pk[0], pk[1], pk[2], pk[3]};
    *(uint4*)(ymix + (long)r * DM + col + 8) = uint4{pk[4], pk[5], pk[6], pk[7]};
  }
}

#define FFN_G1(woff, rows) do { kind = K_GEMM; g.A0 = H; g.B0 = (const u16*)(ws + (woff)); g.Mt = (rows) / 128; g.Ntl = 22; g.wide = 1; g.ars = 32; g.aks = (long)NT * 32; g.brs = 32; g.bks = (long)5632 * 32; g.epi = EPI_SWIGLU; g.C = H1; g.ldc = DFF; } while (0)
#define FFN_G2(woff, rows) do { kind = K_GEMM; g.A0 = H1; g.lda = DFF; g.B0 = (const u16*)(ws + (woff)); g.ldb = DFF; g.K = DFF; g.Mt = (rows) / 128; g.Ntl = 4; g.wide = 1; \
      g.ars = 32; g.aks = (long)NT * 32; g.brs = 32; g.bks = (long)1024 * 32; g.epi = EPI_BF16; g.C = Y; } while (0)
#define ROWD(xsl, xsc, yy, modl, gi_, gs_, lnidx, layer, modn, si_, ci_, hh, rows) do { kind = K_ROW; r.xs_lat = (xsl); r.xs_ctx = (xsc); r.y = (yy); r.modL = (modl); r.gi = (gi_); \
      r.gscale = (gs_); r.lng = p.ln_g + ((layer) * 3 + (lnidx)) * DM; r.lnb = p.ln_b + ((layer) * 3 + (lnidx)) * DM; r.modN = (modn); r.si = (si_); r.ci = (ci_); r.h = (hh); r.nrows = (rows); } while (0)
enum { K_NONE = 0, K_PREP0, K_PREP1, K_GEMM, K_ROW, K_SCONV, K_EVMIX, K_SCAN, K_READOUT, K_ZTRANS };

struct RowD {
  const float *xs_lat, *xs_ctx;
  const u16* y;
  const float *modL, *lng, *lnb, *modN;
  u16* h;
  int gi, si, ci, nrows;
  float gscale;
};

__global__ void __launch_bounds__(NTHR, 2) fwd_megakernel(Params p) {
  extern __shared__ __attribute__((aligned(16))) char smem[];
  cg::grid_group grid = cg::this_grid();
  char* ws = p.ws;
  float* modv = (float*)(ws + OFF_MOD);
  float* XC = (float*)(ws + OFF_XC);
  u16* H = (u16*)(ws + OFF_H);
  u16* H1 = (u16*)(ws + OFF_H1);
  u16* Y = (u16*)(ws + OFF_Y);
  u16* T = (u16*)(ws + OFF_T);
  u16* V = (u16*)(ws + OFF_V);
  u16* YE = (u16*)(ws + OFF_YE);
  u16* DC = (u16*)(ws + OFF_DC);
  u16* DS = (u16*)(ws + OFF_DS);
  float* HD2 = (float*)(ws + OFF_HD2);
  float* FR = (float*)(ws + OFF_FR);
  _Float16* PROJ = (_Float16*)(ws + OFF_PROJ);
  u16* OB = (u16*)(ws + OFF_O);
  u16* YO = (u16*)(ws + OFF_YO);
  const float* mod0 = modv;
  const float* mod1 = modv + (long)17 * 9216;

  int dup_done = 0;
  volatile LAS unsigned* xb_st = (volatile LAS unsigned*)(smem + LDS_BYTES - 16);
  if (threadIdx.x == 0) { xb_st[0] = 0u; xb_st[1] = 0u; }
  __syncthreads();
  const XcdBarrier xb = xcd_barrier_post((unsigned*)(ws + OFF_BAR), xb_st);
  for (int ph = 0; ph < NPHASE; ++ph) {
    int tidx_ = __builtin_amdgcn_workitem_id_x(), bidx_ = __builtin_amdgcn_workgroup_id_x();
    asm volatile("" : "+v"(tidx_));
    asm volatile("" : "+s"(bidx_));
    int kind = K_NONE;
    GemmD g{};
    RowD r{};
    g.nseg = 1; g.nbatch = 1; g.scale = 1.f; g.lda = DM; g.ldb = DM; g.K = DM; g.ldc = DM;
    switch (ph) {
      case 0: kind = K_PREP0; break;
      case 1: kind = K_PREP1; break;
      case 2: FFN_G1(OFF_W0_FFN_IN0, NT); break;
      case 3: FFN_G2(OFF_W0_FFN_OUT0, NT); break;
      case 4: ROWD(p.x, p.ctx, Y, mod0, 2, 0.5f, 0, 0, mod0, 3, 4, H, NT); break;
      case 5:
        kind = K_GEMM; g.A0 = H; g.B0 = (const u16*)(ws + OFF_W0_EV_IN); g.Mt = NT / 128; g.Ntl = 10; g.wide = 1; g.ars = 32; g.aks = (long)NT * 32; g.brs = 32; g.bks = (long)2560 * 32; g.epi = EPI_BF16_T; g.C = T; g.ldc = NT;
        break;
      case 6: kind = K_SCONV; break;
      case 7: kind = K_EVMIX; break;
      case 8: kind = K_ZTRANS; break;
      case 9:
        kind = K_GEMM; g.A0 = H; g.B0 = (const u16*)(ws + OFF_W0_EV_OUT); g.Mt = NT / 128; g.Ntl = 8; g.epi = EPI_BF16; g.C = YE;
        break;
      case 10: ROWD(p.out, XC, YE, mod0, 5, 1.f, 1, 0, mod0, 6, 7, H, NT); break;
      case 11: FFN_G1(OFF_W0_FFN_IN1, NT); break;
      case 12: FFN_G2(OFF_W0_FFN_OUT1, NT); break;
      case 13: ROWD(p.out, XC, Y, mod0, 8, 0.5f, 2, 0, mod1, 0, 1, H, NT); break;
      case 14: FFN_G1(OFF_W1_FFN_IN0, NT); break;
      case 15: FFN_G2(OFF_W1_FFN_OUT0, NT); break;
      case 16: ROWD(p.out, XC, Y, mod1, 2, 0.5f, 0, 1, mod1, 3, 4, H, NT); break;
      case 17:
        kind = K_GEMM; g.A0 = H; g.B0 = (const u16*)(ws + OFF_W1_OD_IN); g.Mt = NT / 128; g.Ntl = 17; g.wide = 1; g.ars = 32; g.aks = (long)NT * 32; g.brs = 32; g.bks = (long)4352 * 32; g.epi = EPI_F16; g.C = PROJ; g.ldc = 4128; g.ncols = 4128;
        break;
      case 18: kind = K_SCAN; break;
      case 19: kind = K_READOUT; break;
      case 20:
        kind = K_GEMM; g.A0 = H; g.B0 = (const u16*)(ws + OFF_W1_OD_OUT); g.Mt = NLAT / 128; g.Ntl = 8; g.epi = EPI_BF16; g.C = YO;
        break;
      case 21: ROWD(p.out, XC, YO, mod1, 5, 1.f, 1, 1, mod1, 6, 7, H, NLAT); break;
      case 22: FFN_G1(OFF_W1_FFN_IN1, NLAT); break;
      case 23: FFN_G2(OFF_W1_FFN_OUT1, NLAT); break;
      case 24: ROWD(p.out, XC, Y, mod1, 8, 0.5f, 2, 1, mod1, 0, 1, nullptr, NLAT); break;
      default: break;
    }
    switch (kind) {
      case K_PREP0: {
        mod_gemv(tidx_, bidx_, smem, p, modv);
        for (int ls = 0; ls < 4; ++ls) {
          const size_t io = (ls == 0) ? OFF_W0_FFN_IN0 : (ls == 1) ? OFF_W0_FFN_IN1 : (ls == 2) ? OFF_W1_FFN_IN0 : OFF_W1_FFN_IN1;
          const size_t oo = (ls == 0) ? OFF_W0_FFN_OUT0 : (ls == 1) ? OFF_W0_FFN_OUT1 : (ls == 2) ? OFF_W1_FFN_OUT0 : OFF_W1_FFN_OUT1;
          convert_job(tidx_, bidx_, smem, p.ffn_w_in + (long)ls * 1024 * 5632, 5632, 1024, 5632, 5632, (u16*)(ws + io), 1, 32, (long)5632 * 32);
          convert_job(tidx_, bidx_, smem, p.ffn_w_out + (long)ls * DFF * 1024, 1024, DFF, 1024, 1024, (u16*)(ws + oo), 0, 32, (long)1024 * 32);
        }
        for (int jb = 0; jb < 4; ++jb) {
          const float* src = (jb == 0) ? p.ev_w_in + 512 : (jb == 1) ? p.ev_w_out : (jb == 2) ? p.od_w_in : p.od_w_out;
          const int pitch = (jb == 0) ? 2048 : (jb == 2) ? 4128 : 1024;
          const int nsrc = (jb == 0) ? 1536 : (jb == 2) ? 4128 : 1024;
          const int nout = (jb == 0) ? 1536 : (jb == 2) ? 4352 : 1024;
          u16* dst = (u16*)(ws + ((jb == 0) ? OFF_W0_EV_IN + (size_t)1024 * 32 * 2 : (jb == 1) ? OFF_W0_EV_OUT : (jb == 2) ? OFF_W1_OD_IN : OFF_W1_OD_OUT));
          const long brs = (jb == 0 || jb == 2) ? 32 : 1024;
          const long bks = (jb == 0) ? (long)2560 * 32 : (jb == 2) ? (long)4352 * 32 : 32;
          convert_job(tidx_, bidx_, smem, src, pitch, 1024, nsrc, nout, dst, 0, brs, bks);
        }
        fusew_job(tidx_, bidx_, smem, p.ev_w_in, (u16*)(ws + OFF_W0_EV_IN));
        dft_job(tidx_, bidx_, DC, DS);
        hd2_job(tidx_, bidx_, smem, p, HD2);
        if (bidx_ == 0) {
          float* lb = (float*)(ws + OFF_LB);
          for (int c2 = tidx_; c2 < 512; c2 += NTHR) lb[c2] = 1.f / (1.f + expf(p.hg_lb[c2] - p.hg_lb[512 + c2]));
        }
      } break;
      case K_PREP1: {
        rowpass<4>(tidx_, bidx_, p.x, p.ctx, nullptr, nullptr, false, nullptr, nullptr, 0, 0.f, nullptr, nullptr, mod0, 0, 1, H, 0, NLAT);
        rowpass<2>(tidx_, bidx_, p.x, p.ctx, nullptr, nullptr, false, nullptr, nullptr, 0, 0.f, nullptr, nullptr, mod0, 0, 1, H, NLAT, NT);
        fraw_job(tidx_, bidx_, smem, p, HD2, FR);
      } break;
      case K_GEMM: gemm_job(tidx_, bidx_, smem, g); break;
      case K_ROW:
        rowpass<4>(tidx_, bidx_, r.xs_lat, r.xs_ctx, p.out, XC, true, r.y, r.modL, r.gi, r.gscale, r.lng, r.lnb, r.modN, r.si, r.ci, r.h, 0, NLAT);
        if (r.nrows > NLAT)
          rowpass<2>(tidx_, bidx_, r.xs_lat, r.xs_ctx, p.out, XC, true, r.y, r.modL, r.gi, r.gscale, r.lng, r.lnb, r.modN, r.si, r.ci, r.h, NLAT, r.nrows);
        break;
      case K_SCAN: scan_job(tidx_, bidx_, smem, p, PROJ, OB, H, (const float*)(ws + OFF_LB)); break;
      case K_READOUT: readout_job(tidx_, bidx_, p, PROJ, OB, H); break;
      case K_ZTRANS: ztrans_job(tidx_, bidx_, smem, T + (long)1536 * NT, H); break;
      case K_SCONV: sconv_job(tidx_, bidx_, p, T + (long)1024 * NT, V); break;
      case K_EVMIX: {
        toep_job(tidx_, bidx_, smem, p, FR, V, T + (long)1024 * NT, T + (long)1536 * NT);
        GemmD f{};
        f.A0 = DC; f.A1 = DS; f.lda = 2048; f.B0 = T; f.B1 = T + (long)512 * NT; f.ldb = NT; f.bsB = 2048; f.K = 2048; f.nseg = 2;
        f.Mt = 16; f.Ntl = 2; f.wide = 1; f.nbatch = 16; f.bsCrow = 2048; f.crow0 = 0; f.epi = EPI_BF16; f.C = H; f.ldc = DM; f.scale = 0.0027621358640099515f;
        gemm_job(tidx_, bidx_, smem, f);
        f.lda = 8 * 2048; f.B0 = T + NLAT; f.B1 = T + (long)512 * NT + NLAT; f.bsB = 256; f.K = 256; f.Mt = 2; f.bsCrow = 256; f.crow0 = NLAT;
        f.scale = 0.0078125f;
        gemm_job(tidx_, bidx_, smem, f);
      } break;
      default: break;
    }
    if (ph + 1 < NPHASE) {
      if (ph == 0) grid.sync();
      else xcd_barrier(xb);
    }
    if ((((DUPMASK >> kind) & 1) || ph == DUPPH) && dup_done != ph + 1) { dup_done = ph + 1; --ph; }
  }
}

extern "C" void kernel_launch(void* const* d_in, const int* in_sizes, int n_in, void* d_out, int out_size, void* d_ws,
                              size_t ws_size, hipStream_t stream) {
  static int grid_blocks = 0;
  if (!grid_blocks) {
    int dev = 0, cus = 0, per_cu = 0;
    (void)hipGetDevice(&dev);
    (void)hipDeviceGetAttribute(&cus, hipDeviceAttributeMultiprocessorCount, dev);
    (void)hipFuncSetAttribute((const void*)fwd_megakernel, hipFuncAttributeMaxDynamicSharedMemorySize, LDS_BYTES);
    (void)hipOccupancyMaxActiveBlocksPerMultiprocessor(&per_cu, (const void*)fwd_megakernel, NTHR, LDS_BYTES);
    if (per_cu < 1) per_cu = 1;
    if (per_cu > 2) per_cu = 2;
    grid_blocks = cus * per_cu;
    if (ws_size < WS_NEED) fprintf(stderr, "workspace too small: %zu < %zu\n", ws_size, (size_t)WS_NEED);
  }
  (void)hipMemsetAsync((char*)d_ws + OFF_BAR, 0, 16384, stream);
  Params p{};
  const float** pp = (const float**)&p;
  for (int i = 0; i < 28; ++i) pp[i] = (const float*)d_in[i];
  p.out = (float*)d_out;
  p.ws = (char*)d_ws;
  void* args[] = {&p};
  hipError_t e = hipLaunchCooperativeKernel((const void*)fwd_megakernel, dim3(grid_blocks), dim3(NTHR), args, LDS_BYTES, stream);
  if (e != hipSuccess) fprintf(stderr, "cooperative launch failed: %s (grid %d)\n", hipGetErrorString(e), grid_blocks);
}
```
